# Optimizing an MI355X kernel written in HIP

```python
import math
import jax, jax.numpy as jnp
from jax import lax
import numpy as np

D_MODEL = 4096
BATCH = 4
SEQ = 2048
DEPTH = 1
DEC_BATCH = 128
DEC_SEQ = 8
PAST_LEN = 16384
PAGE_SIZE = 128

RET_HEADS = 16
RET_DK = 128
RET_DV = 256
RET_QK = RET_HEADS * RET_DK
RET_V = RET_HEADS * RET_DV
RET_CHUNK = 128
ROPE_BASE = 10000.0

S5_WIDTH = D_MODEL // 2
S5_GROUP = 16
S5_GROUPS = S5_WIDTH // S5_GROUP
S5_STATE = 64

X_HEADS = 4
X_WIDTH = D_MODEL // 2
X_HD = X_WIDTH // X_HEADS
MEM_LEN = 256

DN_ALPHA = (2.0 * DEPTH) ** 0.25
DN_BETA = (8.0 * DEPTH) ** -0.25
LN_EPS = 1e-5
GN_EPS = 1e-5

IN_SPLIT_SIZES = (RET_QK, RET_QK, RET_V, RET_V, S5_WIDTH, S5_WIDTH, X_WIDTH, X_WIDTH, D_MODEL, D_MODEL, D_MODEL)
IN_WIDTH = 2 * RET_QK + 2 * RET_V + 2 * S5_WIDTH + 2 * X_WIDTH + 3 * D_MODEL

kernel_name = "retnet_s5_memory_hybrid_step"

F32 = jnp.float32


def _split_points():
    pts, acc = [], 0
    for s in IN_SPLIT_SIZES[:-1]:
        acc += s
        pts.append(acc)
    return pts


def layer_norm(x, g, b):
    xf = x.astype(F32)
    mu = jnp.mean(xf, -1, keepdims=True)
    var = jnp.mean(jnp.square(xf - mu), -1, keepdims=True)
    return ((xf - mu) * lax.rsqrt(var + LN_EPS) * g.astype(F32) + b.astype(F32)).astype(x.dtype)


def head_norm(o):
    of = o.astype(F32)
    mu = jnp.mean(of, -1, keepdims=True)
    var = jnp.mean(jnp.square(of - mu), -1, keepdims=True)
    return ((of - mu) * lax.rsqrt(var + GN_EPS)).astype(o.dtype)


def rotary(x, pos):
    half = RET_DK // 2
    inv = 1.0 / (ROPE_BASE ** (jnp.arange(half, dtype=F32) / half))
    ang = pos.astype(F32)[:, None] * inv[None, :]
    cos = jnp.cos(ang)[None, :, None, :]
    sin = jnp.sin(ang)[None, :, None, :]
    xr = x.astype(F32).reshape(x.shape[:-1] + (half, 2))
    x0, x1 = xr[..., 0], xr[..., 1]
    out = jnp.stack([x0 * cos - x1 * sin, x0 * sin + x1 * cos], -1)
    return out.reshape(x.shape).astype(x.dtype)


def ret_log_decay():
    return jnp.log1p(-jnp.exp2(-5.0 - jnp.arange(RET_HEADS, dtype=F32)))


def retention(q, k, v, s0, chunk):
    B, L = q.shape[0], q.shape[1]
    nc = L // chunk
    lg = ret_log_decay()
    idx = jnp.arange(chunk, dtype=F32)
    rel = idx[:, None] - idx[None, :]
    inner = jnp.where(rel[None] >= 0, jnp.exp(lg[:, None, None] * jnp.maximum(rel, 0.0)[None]), 0.0)
    xi = jnp.exp(lg[:, None] * (idx + 1.0)).T[None, :, :, None]
    zeta = jnp.exp(lg[:, None] * (chunk - 1.0 - idx))
    g_chunk = jnp.exp(lg * chunk)[None, :, None, None]

    def to_chunks(t):
        t = t.astype(F32)
        return t.reshape((B, nc, chunk) + t.shape[2:]).swapaxes(0, 1)

    def step(s, inp):
        qc, kc, vc = inp
        sc = jnp.einsum('bihd,bjhd->bhij', qc, kc) * inner[None]
        o = jnp.einsum('bhij,bjhe->bihe', sc, vc) + jnp.einsum('bihd,bhde->bihe', qc, s) * xi
        s_new = g_chunk * s + jnp.einsum('bjhd,bjhe,hj->bhde', kc, vc, zeta)
        return s_new, o

    s_fin, o = lax.scan(step, s0.astype(F32), (to_chunks(q), to_chunks(k), to_chunks(v)))
    o = o.swapaxes(0, 1).reshape(B, L, RET_HEADS, RET_DV)
    return o.astype(v.dtype), s_fin.astype(s0.dtype)


def s5_discretize(a_re, a_im, log_step, b_re, b_im):
    dt = jnp.exp(log_step.astype(F32))[:, None]
    ar, ai = a_re.astype(F32), a_im.astype(F32)
    mag = jnp.exp(dt * ar)
    abar_re = mag * jnp.cos(dt * ai)
    abar_im = mag * jnp.sin(dt * ai)
    den = ar * ar + ai * ai
    x_re = abar_re - 1.0
    f_re = (x_re * ar + abar_im * ai) / den
    f_im = (abar_im * ar - x_re * ai) / den
    br, bi = b_re.astype(F32), b_im.astype(F32)
    bbar_re = f_re[..., None] * br - f_im[..., None] * bi
    bbar_im = f_re[..., None] * bi + f_im[..., None] * br
    return abar_re, abar_im, bbar_re, bbar_im


def s5_branch(u, h0_re, h0_im, a_re, a_im, log_step, b_re, b_im, c_re, c_im, d_skip):
    B, L = u.shape[0], u.shape[1]
    abar_re, abar_im, bbar_re, bbar_im = s5_discretize(a_re, a_im, log_step, b_re, b_im)
    uf = u.astype(F32)
    ug = uf.reshape(B, L, S5_GROUPS, S5_GROUP)
    bu_re = jnp.einsum('blgp,gnp->blgn', ug, bbar_re)
    bu_im = jnp.einsum('blgp,gnp->blgn', ug, bbar_im)
    h0r, h0i = h0_re.astype(F32), h0_im.astype(F32)
    bu_re = bu_re.at[:, 0].add(abar_re * h0r - abar_im * h0i)
    bu_im = bu_im.at[:, 0].add(abar_re * h0i + abar_im * h0r)
    a_r = jnp.broadcast_to(abar_re, bu_re.shape)
    a_i = jnp.broadcast_to(abar_im, bu_im.shape)

    def combine(e1, e2):
        a1r, a1i, b1r, b1i = e1
        a2r, a2i, b2r, b2i = e2
        return (a1r * a2r - a1i * a2i,
                a1r * a2i + a1i * a2r,
                a2r * b1r - a2i * b1i + b2r,
                a2r * b1i + a2i * b1r + b2i)

    _, _, h_re, h_im = lax.associative_scan(combine, (a_r, a_i, bu_re, bu_im), axis=1)
    y = (jnp.einsum('blgn,gpn->blgp', h_re, c_re.astype(F32))
         - jnp.einsum('blgn,gpn->blgp', h_im, c_im.astype(F32)))
    y = y.reshape(B, L, S5_WIDTH) + d_skip.astype(F32) * uf
    return y.astype(u.dtype), h_re[:, -1].astype(h0_re.dtype), h_im[:, -1].astype(h0_im.dtype)


def cross_attend(q, mk, mv):
    s = jnp.einsum('blhd,bmhd->bhlm', q, mk).astype(F32) * (X_HD ** -0.5)
    p = jax.nn.softmax(s, axis=-1).astype(mv.dtype)
    return jnp.einsum('bhlm,bmhd->blhd', p, mv)


def memory_kv(mem, w_mem_kv):
    B = mem.shape[0]
    kv = mem @ w_mem_kv
    mk, mv = jnp.split(kv, 2, axis=-1)
    return mk.reshape(B, MEM_LEN, X_HEADS, X_HD), mv.reshape(B, MEM_LEN, X_HEADS, X_HD)


def mixer_layer(x, pos, s_ret, h_re, h_im, mem_k, mem_v, chunk,
                w_in, a_re, a_im, log_step, b_re, b_im, c_re, c_im, d_skip, w_glu,
                w_proj_a, w_proj_b, w_proj_c, w_out, ln_g, ln_b):
    B, L = x.shape[0], x.shape[1]
    z = x @ w_in
    q, k, v, g_ret, u, g_s5, qx, g_x, m_a, m_b, m_c = jnp.split(z, _split_points(), axis=-1)

    q = rotary(q.reshape(B, L, RET_HEADS, RET_DK), pos)
    k = rotary(k.reshape(B, L, RET_HEADS, RET_DK), pos) * (RET_DK ** -0.5)
    v = v.reshape(B, L, RET_HEADS, RET_DV)
    o_ret, s_ret_new = retention(q, k, v, s_ret, chunk)
    o_ret = head_norm(o_ret).reshape(B, L, RET_V) * jax.nn.silu(g_ret)

    y_s5, h_re_new, h_im_new = s5_branch(u, h_re, h_im, a_re, a_im, log_step, b_re, b_im, c_re, c_im, d_skip)
    gl = jax.nn.gelu(y_s5)
    glu_a, glu_b = jnp.split(gl @ w_glu, 2, axis=-1)
    o_s5 = glu_a * jax.nn.sigmoid(glu_b) * jax.nn.silu(g_s5)

    o_x = cross_attend(qx.reshape(B, L, X_HEADS, X_HD), mem_k, mem_v).reshape(B, L, X_WIDTH) * jax.nn.silu(g_x)

    merged = (jax.nn.sigmoid(m_a) * (o_ret @ w_proj_a)
              + jax.nn.sigmoid(m_b) * (o_s5 @ w_proj_b)
              + jax.nn.sigmoid(m_c) * (o_x @ w_proj_c))
    out = merged @ w_out
    x_new = layer_norm(DN_ALPHA * x + out, ln_g, ln_b)
    return x_new, s_ret_new, h_re_new, h_im_new


def setup_inputs(seed: int = 0) -> dict:
    key = jax.random.key(seed)
    ks = jax.random.split(key, 32)
    nrm = jax.random.normal
    Dp = DEPTH
    inp = {}
    inp["x_prompt"] = nrm(ks[0], (BATCH, SEQ, D_MODEL), F32)
    inp["x_sample"] = nrm(ks[1], (DEC_BATCH, DEC_SEQ, D_MODEL), F32)
    inp["mem_prompt"] = nrm(ks[2], (BATCH, MEM_LEN, D_MODEL), F32)
    inp["state_ret"] = nrm(ks[3], (Dp, DEC_BATCH, RET_HEADS, RET_DK, RET_DV), F32)
    inp["state_s5_re"] = 0.1 * nrm(ks[4], (Dp, DEC_BATCH, S5_GROUPS, S5_STATE), F32)
    inp["state_s5_im"] = 0.1 * nrm(ks[5], (Dp, DEC_BATCH, S5_GROUPS, S5_STATE), F32)
    inp["cache_mem_k"] = nrm(ks[6], (Dp, DEC_BATCH, MEM_LEN, X_HEADS, X_HD), F32)
    inp["cache_mem_v"] = nrm(ks[7], (Dp, DEC_BATCH, MEM_LEN, X_HEADS, X_HD), F32)
    inp["w_in"] = nrm(ks[8], (Dp, D_MODEL, IN_WIDTH), F32) * (D_MODEL ** -0.5)
    inp["w_mem_kv"] = nrm(ks[9], (Dp, D_MODEL, 2 * X_WIDTH), F32) * (D_MODEL ** -0.5)
    inp["s5_a_re"] = -0.5 + 0.01 * nrm(ks[10], (Dp, S5_GROUPS, S5_STATE), F32)
    inp["s5_a_im"] = (jnp.pi * jnp.arange(S5_STATE, dtype=F32))[None, None, :] + 0.01 * nrm(ks[11], (Dp, S5_GROUPS, S5_STATE), F32)
    inp["s5_log_step"] = jax.random.uniform(ks[12], (Dp, S5_GROUPS), F32, minval=math.log(1e-3), maxval=math.log(1e-1))
    inp["s5_b_re"] = nrm(ks[13], (Dp, S5_GROUPS, S5_STATE, S5_GROUP), F32) * ((2.0 * S5_GROUP) ** -0.5)
    inp["s5_b_im"] = nrm(ks[14], (Dp, S5_GROUPS, S5_STATE, S5_GROUP), F32) * ((2.0 * S5_GROUP) ** -0.5)
    inp["s5_c_re"] = nrm(ks[15], (Dp, S5_GROUPS, S5_GROUP, S5_STATE), F32) * ((2.0 * S5_STATE) ** -0.5)
    inp["s5_c_im"] = nrm(ks[16], (Dp, S5_GROUPS, S5_GROUP, S5_STATE), F32) * ((2.0 * S5_STATE) ** -0.5)
    inp["s5_d"] = nrm(ks[17], (Dp, S5_WIDTH), F32)
    inp["w_glu"] = nrm(ks[18], (Dp, S5_WIDTH, 2 * S5_WIDTH), F32) * (S5_WIDTH ** -0.5)
    inp["w_proj_a"] = nrm(ks[19], (Dp, RET_V, D_MODEL), F32) * (RET_V ** -0.5) * DN_BETA
    inp["w_proj_b"] = nrm(ks[20], (Dp, S5_WIDTH, D_MODEL), F32) * (S5_WIDTH ** -0.5) * DN_BETA
    inp["w_proj_c"] = nrm(ks[21], (Dp, X_WIDTH, D_MODEL), F32) * (X_WIDTH ** -0.5) * DN_BETA
    inp["w_out"] = nrm(ks[22], (Dp, D_MODEL, D_MODEL), F32) * (D_MODEL ** -0.5) * DN_BETA
    inp["ln_g"] = 1.0 + 0.01 * nrm(ks[23], (Dp, D_MODEL), F32)
    inp["ln_b"] = 0.01 * nrm(ks[24], (Dp, D_MODEL), F32)
    return inp


def reference(x_prompt, x_sample, mem_prompt, state_ret, state_s5_re, state_s5_im, cache_mem_k, cache_mem_v,
              w_in, w_mem_kv, s5_a_re, s5_a_im, s5_log_step, s5_b_re, s5_b_im, s5_c_re, s5_c_im, s5_d, w_glu,
              w_proj_a, w_proj_b, w_proj_c, w_out, ln_g, ln_b):
    pos_p = jnp.arange(SEQ, dtype=jnp.int32)
    pos_s = PAST_LEN + jnp.arange(DEC_SEQ, dtype=jnp.int32)
    chunk_p = min(RET_CHUNK, SEQ)
    yp, ys = x_prompt, x_sample
    ret_p, hre_p, him_p, mk_p_all, mv_p_all = [], [], [], [], []
    ret_s, hre_s, him_s = [], [], []
    for l in range(DEPTH):
        lw = (w_in[l], s5_a_re[l], s5_a_im[l], s5_log_step[l], s5_b_re[l], s5_b_im[l], s5_c_re[l], s5_c_im[l],
              s5_d[l], w_glu[l], w_proj_a[l], w_proj_b[l], w_proj_c[l], w_out[l], ln_g[l], ln_b[l])
        mk_p, mv_p = memory_kv(mem_prompt, w_mem_kv[l])
        s0 = jnp.zeros((BATCH, RET_HEADS, RET_DK, RET_DV), x_prompt.dtype)
        h0 = jnp.zeros((BATCH, S5_GROUPS, S5_STATE), x_prompt.dtype)
        yp, sr, hr, hi = mixer_layer(yp, pos_p, s0, h0, h0, mk_p, mv_p, chunk_p, *lw)
        ret_p.append(sr); hre_p.append(hr); him_p.append(hi); mk_p_all.append(mk_p); mv_p_all.append(mv_p)
        ys, sr, hr, hi = mixer_layer(ys, pos_s, state_ret[l], state_s5_re[l], state_s5_im[l],
                                     cache_mem_k[l], cache_mem_v[l], DEC_SEQ, *lw)
        ret_s.append(sr); hre_s.append(hr); him_s.append(hi)
    return (yp, ys,
            jnp.stack(ret_p), jnp.stack(hre_p), jnp.stack(him_p), jnp.stack(mk_p_all), jnp.stack(mv_p_all),
            jnp.stack(ret_s), jnp.stack(hre_s), jnp.stack(him_s))
```

```cpp
#include <hip/hip_runtime.h>
#include <cstdio>
#include <cstdint>
#include <cmath>

#ifndef REP_P0
#define REP_P0 1
#endif
#ifndef REP_P1
#define REP_P1 1
#endif
#ifndef REP_P2
#define REP_P2 1
#endif
#ifndef REP_RP
#define REP_RP REP_P2
#endif
#ifndef REP_XP
#define REP_XP REP_P2
#endif
#ifndef REP_SP
#define REP_SP REP_P2
#endif
#ifndef REP_SS
#define REP_SS REP_P2
#endif
#ifndef REP_XS
#define REP_XS REP_P2
#endif
#ifndef REP_RS
#define REP_RS REP_P2
#endif
#ifndef MK_N_LAUNCHES
#define MK_N_LAUNCHES 1
#endif

#define LAS __attribute__((address_space(3)))
typedef unsigned short bf16_t;
typedef short bf16x8 __attribute__((ext_vector_type(8)));
typedef float f32x4 __attribute__((ext_vector_type(4)));
typedef float f32x16 __attribute__((ext_vector_type(16)));
typedef unsigned u32x4 __attribute__((ext_vector_type(4)));
typedef unsigned u32x2 __attribute__((ext_vector_type(2)));

constexpr int DM = 4096, TP = 8192, TS = 1024, TT = 9216;
#ifndef LDPAD
#define LDPAD 64
#endif
constexpr int ZLD = 32768 + LDPAD, ALD = 8192 + LDPAD, LDX = 4096 + LDPAD, LDG = 2048 + LDPAD;
constexpr int LD8 = 4096 + 128, LDA8 = 8192 + 128;
constexpr int LDM8 = 12288 + 128;
constexpr int LDG8 = 2048 + 128;
constexpr float ACS = 8.f;
constexpr int ZQ = 0, ZK = 2048, ZV = 4096, ZGR = 8192, ZU = 12288, ZGS = 14336, ZQX = 16384, ZGX = 18432, ZMA = 20480;
constexpr int AC_RET = 0, AC_S5 = 4096, AC_X = 6144;
constexpr float DN_ALPHA = 1.189207115002721f;
constexpr size_t O_YP = 0, O_YS = 33554432, O_RETP = 37748736, O_S5RP = 39845888, O_S5IP = 39878656, O_MK = 39911424, O_MV = 42008576,
                 O_RETS = 44105728, O_S5RS = 111214592, O_S5IS = 112263168, O_END = 113311744;
constexpr size_t MiB = 1u << 20;
constexpr size_t WS_CTL = 0, CTL_ZERO_BYTES = 262144;
constexpr size_t WS_XB = 1 * MiB, WS_MEMB = 75 * MiB, WS_WIN = 84 * MiB, WS_WMKV = 344 * MiB, WS_WGLU = 377 * MiB, WS_WCAT = 394 * MiB, WS_WOUT = 459 * MiB,
                 WS_Z = 492 * MiB, WS_ACAT = 1070 * MiB, WS_GL = 1216 * MiB, WS_MERGED = 1254 * MiB, WS_KVB = 1328 * MiB, WS_ROPE = 1336 * MiB, WS_S5 = 1338 * MiB,
                 WS_SLAB = 1340 * MiB, WS_XB8 = 1404 * MiB, WS_ZM8 = 1444 * MiB, WS_END = 1554 * MiB;
constexpr size_t WS_WINB = WS_WIN, WS_WIN8 = WS_WIN + 70 * MiB;
static_assert(WS_WINB + (size_t)8192 * LDX * 2 <= WS_WIN8 && WS_WIN8 + (size_t)24576 * LD8 <= WS_WMKV && WS_XB8 + (size_t)TT * LD8 <= WS_ZM8 && WS_ZM8 + (size_t)TT * LDM8 <= WS_END, "d_ws map (fp8)");
static_assert(WS_XB + (size_t)TT * LDX * 2 <= WS_MEMB && WS_MEMB + (size_t)1024 * LDX * 2 <= WS_WIN && WS_WIN + (size_t)32768 * LDX * 2 <= WS_WMKV && WS_WMKV + (size_t)4096 * LDX * 2 <= WS_WGLU &&
              WS_WGLU + (size_t)4096 * LDG * 2 <= WS_WCAT && WS_WCAT + (size_t)4096 * ALD * 2 <= WS_WOUT && WS_WOUT + (size_t)4096 * LDX * 2 <= WS_Z && WS_Z + (size_t)TT * ZLD * 2 <= WS_ACAT &&
              WS_ACAT + (size_t)TT * ALD * 2 <= WS_GL && WS_GL + (size_t)TT * LDG * 2 <= WS_MERGED && WS_MERGED + (size_t)TT * LDX * 2 <= WS_KVB, "d_ws map");
constexpr size_t S5_ABAR = 0, S5_BFRAG = 65536, S5_CFRAG = 65536 + 524288;
constexpr int CW_QUEUE = 64, CW_BAR = 4096, CW_TICKET = 16384;
constexpr int LDS_BYTES = 147456;

__device__ __forceinline__ float bf2f(unsigned short b) { return __uint_as_float(((unsigned)b) << 16); }
__device__ __forceinline__ unsigned short f2bf(float f) { unsigned u = __float_as_uint(f); return (unsigned short)((u + 0x7fffu + ((u >> 16) & 1u)) >> 16); }
__device__ __forceinline__ unsigned cvt_pk_bf16(float lo, float hi) { unsigned r; asm volatile("v_cvt_pk_bf16_f32 %0, %1, %2" : "=v"(r) : "v"(lo), "v"(hi)); return r; }
__device__ __forceinline__ float sat8(float v) { return __builtin_amdgcn_fmed3f(v, -448.f, 448.f); }
__device__ __forceinline__ unsigned pk4_fp8(float a, float b, float c, float d) { unsigned w = 0u; w = __builtin_amdgcn_cvt_pk_fp8_f32(sat8(a), sat8(b), w, false); w = __builtin_amdgcn_cvt_pk_fp8_f32(sat8(c), sat8(d), w, true); return w; }
__device__ __forceinline__ u32x2 pk8_fp8(const f32x4 a, const f32x4 b, float sc) {
    unsigned w0 = 0u, w1 = 0u;
    w0 = __builtin_amdgcn_cvt_pk_fp8_f32(a[0] * sc, a[1] * sc, w0, false); w0 = __builtin_amdgcn_cvt_pk_fp8_f32(a[2] * sc, a[3] * sc, w0, true);
    w1 = __builtin_amdgcn_cvt_pk_fp8_f32(b[0] * sc, b[1] * sc, w1, false); w1 = __builtin_amdgcn_cvt_pk_fp8_f32(b[2] * sc, b[3] * sc, w1, true);
    u32x2 o; o.x = w0; o.y = w1; return o; }
__device__ __forceinline__ u32x2 bf8_to_fp8(const u32x4 v, float sc) {
    u32x2 o; o.x = pk4_fp8(__uint_as_float(v.x << 16) * sc, __uint_as_float(v.x & 0xffff0000u) * sc, __uint_as_float(v.y << 16) * sc, __uint_as_float(v.y & 0xffff0000u) * sc);
    o.y = pk4_fp8(__uint_as_float(v.z << 16) * sc, __uint_as_float(v.z & 0xffff0000u) * sc, __uint_as_float(v.w << 16) * sc, __uint_as_float(v.w & 0xffff0000u) * sc); return o; }
__device__ __forceinline__ unsigned pk4_u8(float a, float b, float c, float d) {
    unsigned w = 0u; w = __builtin_amdgcn_cvt_pk_u8_f32(a, 0, w); w = __builtin_amdgcn_cvt_pk_u8_f32(b, 1, w); w = __builtin_amdgcn_cvt_pk_u8_f32(c, 2, w); w = __builtin_amdgcn_cvt_pk_u8_f32(d, 3, w); return w; }
__device__ __forceinline__ float ub(unsigned w, int k) { return (float)((w >> (8 * k)) & 0xffu); }
__device__ __forceinline__ float fast_rcp(float x) { return __builtin_amdgcn_rcpf(x); }
constexpr float GSC = 16.f;
typedef float f32x2_ __attribute__((ext_vector_type(2)));
__device__ __forceinline__ const unsigned char* gate8(const bf16_t* Z, size_t row, int G, int c) { return (const unsigned char*)(Z + row * ZLD + G) + c; }
__device__ __forceinline__ void unpack4_fp8(unsigned w, float (&g)[4]) { const f32x2_ a = __builtin_amdgcn_cvt_pk_f32_fp8((int)w, false), b = __builtin_amdgcn_cvt_pk_f32_fp8((int)w, true); g[0] = a[0]; g[1] = a[1]; g[2] = b[0]; g[3] = b[1]; }
__device__ __forceinline__ void unpack8_fp8(u32x2 w, float (&g)[8]) { float lo[4], hi[4]; unpack4_fp8(w.x, lo); unpack4_fp8(w.y, hi);
    g[0] = lo[0]; g[1] = lo[1]; g[2] = lo[2]; g[3] = lo[3]; g[4] = hi[0]; g[5] = hi[1]; g[6] = hi[2]; g[7] = hi[3]; }
__device__ __forceinline__ float silu_f(float x) { return x * fast_rcp(1.0f + __expf(-x)); }
__device__ __forceinline__ float sigmoid_f(float x) { x = fminf(fmaxf(x, -30.f), 30.f); return fast_rcp(1.0f + __expf(-x)); }
__device__ __forceinline__ float gelu_tanh_f(float x) { const float z = 0.7978845608028654f * (x + 0.044715f * x * x * x); const float t = 1.0f - 2.0f * fast_rcp(1.0f + __expf(2.0f * z)); return 0.5f * x * (1.0f + t); }
__device__ __forceinline__ float wave_sum(float v) {
#pragma unroll
    for (int o = 1; o < 64; o <<= 1) v += __shfl_xor(v, o);
    return v;
}
__device__ __forceinline__ float wave_max(float v) {
#pragma unroll
    for (int o = 1; o < 64; o <<= 1) v = fmaxf(v, __shfl_xor(v, o));
    return v;
}
template <class T> __device__ __forceinline__ T* opq(T* p) { asm volatile("" : "+v"(p)); return p; }
template <class T> __device__ __forceinline__ LAS T* opq(LAS T* p) { asm volatile("" : "+v"(p)); return p; }
#define GAS __attribute__((address_space(1)))
template <class T> __device__ __forceinline__ GAS T* opqg(T* p) { asm volatile("" : "+v"(p)); return (GAS T*)p; }
template <int CTRL> __device__ __forceinline__ float dpp_mov(float v) { return __builtin_bit_cast(float, __builtin_amdgcn_update_dpp(0, __builtin_bit_cast(int, v), CTRL, 0xf, 0xf, true)); }
__device__ __forceinline__ float row16_sum(float v) { v += dpp_mov<0xB1>(v); v += dpp_mov<0x4E>(v); v += dpp_mov<0x141>(v); v += dpp_mov<0x140>(v); return v; }
__device__ __forceinline__ float row16_max(float v) { v = fmaxf(v, dpp_mov<0xB1>(v)); v = fmaxf(v, dpp_mov<0x4E>(v)); v = fmaxf(v, dpp_mov<0x141>(v)); v = fmaxf(v, dpp_mov<0x140>(v)); return v; }
__device__ __forceinline__ f32x4 mfma16(bf16x8 a, bf16x8 b, f32x4 c) { return __builtin_amdgcn_mfma_f32_16x16x32_bf16(a, b, c, 0, 0, 0); }

#define XB_TMO      128
#define XB_XCNT(j)  (256  + 64 * (j))
#define XB_XSUB(j)  (1280 + 64 * (j))
#define XB_XGEN(j)  (2304 + 64 * (j))
#define XB_TOP      3328
#define XB_TOPGEN   3392
#define XCD_BAR_WORDS 3456
#define XB_SPIN_CAP (1u << 18)
__device__ __forceinline__ unsigned xb_ld(unsigned* p)              { return __hip_atomic_load(p, __ATOMIC_RELAXED, __HIP_MEMORY_SCOPE_AGENT); }
__device__ __forceinline__ unsigned xb_add(unsigned* p, unsigned v) { return __hip_atomic_fetch_add(p, v, __ATOMIC_RELAXED, __HIP_MEMORY_SCOPE_AGENT); }
__device__ __forceinline__ unsigned xb_xcc_id() { return (unsigned)__builtin_amdgcn_s_getreg((3 << 11) | 20) & 0xFu; }
#define XB_SPIN(cond, bar) do { unsigned _sp = 0; while (cond) { __builtin_amdgcn_s_sleep(1); \
    if ((++_sp & 255u) == 0u) { if (xb_ld(&(bar)[XB_TMO])) break; if (_sp > XB_SPIN_CAP) { atomicAdd(&(bar)[XB_TMO], 1u); break; } } } } while (0)
struct XcdBarrier { unsigned* bar; unsigned x; volatile LAS unsigned* st; };
__device__ __forceinline__ XcdBarrier xcd_barrier_post(unsigned* bar, volatile LAS unsigned* st) {
    XcdBarrier b; b.bar = bar; b.x = xb_xcc_id(); b.st = st;
    if (threadIdx.x == 0) (void)xb_add(&bar[XB_XCNT(b.x)], 1u);
    return b;
}
__device__ __forceinline__ void xcd_barrier_complete(unsigned* bar, unsigned x, unsigned& nloc, unsigned& nx) {
    const unsigned G = gridDim.x * gridDim.y * gridDim.z;
    unsigned sum, cnt, mine, sp = 0u;
    for (;;) {
        sum = 0u; cnt = 0u; mine = 0u;
#pragma unroll
        for (unsigned j = 0; j < 16; ++j) { const unsigned c = xb_ld(&bar[XB_XCNT(j)]); sum += c; cnt += (c > 0u) ? 1u : 0u; mine = (j == x) ? c : mine; }
        if (sum == G) break;
        __builtin_amdgcn_s_sleep(1);
        if ((++sp & 255u) == 0u) { if (xb_ld(&bar[XB_TMO])) break; if (sp > XB_SPIN_CAP) { atomicAdd(&bar[XB_TMO], 1u); break; } }
    }
    nloc = mine > 0u ? mine : 1u; nx = cnt > 0u ? cnt : 1u;
}
__device__ __forceinline__ void xcd_barrier(const XcdBarrier& b) {
    asm volatile("s_waitcnt vmcnt(0)" ::: "memory");
    __syncthreads();
    if (threadIdx.x == 0) {
        unsigned* bar = b.bar;
        __builtin_amdgcn_s_waitcnt(0);
        unsigned nloc = b.st[0], nx = b.st[1];
        if (nloc == 0u) { xcd_barrier_complete(bar, b.x, nloc, nx); b.st[0] = nloc; b.st[1] = nx; }
        const unsigned old = xb_add(&bar[XB_XSUB(b.x)], 1u);
        const unsigned gen = old / nloc;
        if (old + 1u == (gen + 1u) * nloc) {
            __builtin_amdgcn_fence(__ATOMIC_RELEASE, "agent");
            asm volatile("s_waitcnt vmcnt(0)" ::: "memory");
            const unsigned og = xb_add(&bar[XB_TOP], 1u);
            const unsigned tg = og / nx;
            if (og + 1u == (tg + 1u) * nx) xb_add(&bar[XB_TOPGEN], 1u);
            else XB_SPIN(xb_ld(&bar[XB_TOPGEN]) == tg, bar);
            __builtin_amdgcn_fence(__ATOMIC_ACQUIRE, "agent");
            xb_add(&bar[XB_XGEN(b.x)], 1u);
            asm volatile("s_waitcnt vmcnt(0)" ::: "memory");
        } else {
            XB_SPIN(xb_ld(&bar[XB_XGEN(b.x)]) == gen, bar);
            __builtin_amdgcn_fence(__ATOMIC_ACQUIRE, "agent");
            asm volatile("s_waitcnt vmcnt(0)" ::: "memory");
        }
    }
    __syncthreads();
}

namespace pg8 {
constexpr int BM = 256, BK = 64, HALF = 128, HTB = HALF * BK * 2, STAGE_BYTES = 8 * HTB, NXCD = 8, WGM = 8;
__host__ __device__ __forceinline__ int lds_byte(int r, int c) { const int st = (r >> 4) * 2 + (c >> 5), rr = r & 15, cc = c & 31, ob = rr * 64 + cc * 2; return st * 1024 + (ob ^ (((ob >> 9) & 1) << 5)); }
__host__ __device__ __forceinline__ void stage_rc(int b, int& R, int& C) { const int st = b / 1024, sb = b % 1024, swz = sb ^ (((sb >> 9) & 1) << 5); R = (st >> 1) * 16 + swz / 64; C = (st & 1) * 32 + (swz % 64) / 2; }
__host__ __device__ __forceinline__ int perm32(int rho) { const int n = rho >> 4, i = rho & 15; return 8 * (i >> 2) + 4 * n + (i & 3); }
struct Unit { int pm, pn; };
struct Gemm { const bf16_t* A; const bf16_t* Bt; int M, N, K, lda, ldb; int sc = 0x7f78; };
struct StaticOrder {
    int nM, nN, nwg, G, c;
    __host__ __device__ void init(int M, int N, int G_, int c_) { nM = M / BM; nN = N / BM; nwg = nM * nN; G = G_; c = c_; }
    __host__ __device__ bool next(int i, Unit& u) const {
        const long L = (long)i * G + c; if (L >= nwg) return false;
        int wgid = (int)L; { const int q = nwg / NXCD, r = nwg % NXCD, xcd = wgid % NXCD, off = wgid / NXCD; wgid = (xcd < r ? xcd * (q + 1) : r * (q + 1) + (xcd - r) * q) + off; }
        const int nig = WGM * nN, gid = wgid / nig, fm = gid * WGM, gsz = (nM - fm) < WGM ? (nM - fm) : WGM;
        u.pm = fm + ((wgid % nig) % gsz); u.pn = (wgid % nig) / gsz; return true;
    }
    __device__ __forceinline__ void a_ready(const Unit&) const {}
    __device__ __forceinline__ void done(const Unit&) const {}
};
template <class Epi, class Sched, bool ALIGN_EPI = false, bool SP2 = false, bool F8 = false>
__device__ __forceinline__ void gemm_phase(LAS unsigned char* lds, const Gemm g, const Sched& S, const Epi& E) {
    const int tid = threadIdx.x, wid = __builtin_amdgcn_readfirstlane(tid >> 6), lane = tid & 63, wr = wid >> 2, wc = wid & 3, fr = lane & 15, fq = lane >> 4;
    const int K = g.K, nt = K / BK;
    unsigned voffA[2], voffB[2];
#pragma unroll
    for (int i = 0; i < 2; ++i) { int R, C; stage_rc(tid * 16 + i * 8192, R, C); const int Rb = Epi::WIDE ? ((R >> 5) * 64 + perm32(R & 31)) : (Epi::PERM ? ((R & ~31) + perm32(R & 31)) : R);
        voffA[i] = (unsigned)(R * g.lda + C) * 2u; voffB[i] = (unsigned)(Rb * g.ldb + C) * 2u; }
    const size_t kstep = (size_t)(BK * 2);
    const size_t hstepA = (size_t)HALF * g.lda * 2, hstepB = (size_t)(Epi::WIDE ? 32 : HALF) * g.ldb * 2;
    const size_t tstepA = 2 * hstepA, tstepB = (size_t)2 * HALF * g.ldb * 2;
    const unsigned ldsw = (unsigned)wid * 1024u;
    const int aoff = lds_byte(wr * 64 + fr, fq * 8), boff = lds_byte(wc * 32 + fr, fq * 8);
#define PG8_SA(b, h) (((b) * 2 + (h)) * HTB)
#define PG8_SB(b, h) ((4 + (b) * 2 + (h)) * HTB)
#define PG8_STAGE(bufoff, gbase, voff) do { _Pragma("unroll") for (int _i = 0; _i < 2; ++_i) \
        __builtin_amdgcn_global_load_lds((const unsigned*)((const char*)(gbase) + (voff)[_i]), (LAS unsigned*)(lds + (bufoff) + ldsw + _i * 8192), 16, 0, 0); } while (0)
#define PG8_LDA(dst, b, h) do { _Pragma("unroll") for (int m = 0; m < 4; ++m) { if constexpr (F8) { const v4i_ lo_ = *(const LAS v4i_*)(lds + PG8_SA(b, h) + aoff + m * 2048), hi_ = *(const LAS v4i_*)(lds + PG8_SA(b, h) + aoff + m * 2048 + 1024); \
            dst##8[m] = __builtin_shufflevector(lo_, hi_, 0, 1, 2, 3, 4, 5, 6, 7); } else { _Pragma("unroll") for (int k = 0; k < 2; ++k) dst[m][k] = *(const LAS bf16x8*)(lds + PG8_SA(b, h) + aoff + m * 2048 + k * 1024); } } } while (0)
#define PG8_LDB(dst, b, h) do { _Pragma("unroll") for (int n = 0; n < 2; ++n) { if constexpr (F8) { const v4i_ lo_ = *(const LAS v4i_*)(lds + PG8_SB(b, h) + boff + n * 2048), hi_ = *(const LAS v4i_*)(lds + PG8_SB(b, h) + boff + n * 2048 + 1024); \
            dst##8[n] = __builtin_shufflevector(lo_, hi_, 0, 1, 2, 3, 4, 5, 6, 7); } else { _Pragma("unroll") for (int k = 0; k < 2; ++k) dst[n][k] = *(const LAS bf16x8*)(lds + PG8_SB(b, h) + boff + n * 2048 + k * 1024); } } } while (0)
#define PG8_MMA(ai, bj, At, Bt) do { __builtin_amdgcn_s_setprio(1); _Pragma("unroll") for (int m = 0; m < 4; ++m) _Pragma("unroll") for (int n = 0; n < 2; ++n) { \
        if constexpr (F8) asm volatile("v_mfma_scale_f32_16x16x128_f8f6f4 %0, %1, %2, %0, %3, %3 op_sel:[0,1,0] op_sel_hi:[0,0,0]" : "+v"(acc[ai][bj][m][n]) : "v"(Bt##8[n]), "v"(At##8[m]), "v"(f8_sc)); \
        else { _Pragma("unroll") for (int k = 0; k < 2; ++k) acc[ai][bj][m][n] = __builtin_amdgcn_mfma_f32_16x16x32_bf16(Bt[n][k], At[m][k], acc[ai][bj][m][n], 0, 0, 0); } } \
        __builtin_amdgcn_s_setprio(0); } while (0)
#define PG8_WAIT_V(n) asm volatile("s_waitcnt vmcnt(" #n ")" ::: "memory")
#define PG8_WAIT_L(n) asm volatile("s_waitcnt lgkmcnt(" #n ")" ::: "memory")
#define PG8_BAR __builtin_amdgcn_s_barrier()
#define PG8_SCHED __builtin_amdgcn_sched_barrier(0)
    Unit cur, nxt; int ui = 0;
    if (!S.next(0, cur)) return;
    f32x4 acc[2][2][4][2];
#pragma unroll
    for (int a = 0; a < 2; ++a)
#pragma unroll
        for (int b = 0; b < 2; ++b)
#pragma unroll
            for (int m = 0; m < 4; ++m)
#pragma unroll
                for (int n = 0; n < 2; ++n) acc[a][b][m][n] = (f32x4){0.f, 0.f, 0.f, 0.f};
    typedef int v8i_ __attribute__((ext_vector_type(8))); typedef int v4i_ __attribute__((ext_vector_type(4)));
    bf16x8 At[4][2], B0[2][2], B1[2][2]; v8i_ At8[4], B08[2], B18[2];
    const int f8_sc = g.sc;
    const char* cA = (const char*)g.A + (size_t)cur.pm * tstepA; const char* cB = (const char*)g.Bt + (size_t)cur.pn * tstepB;
    S.a_ready(cur);
    if constexpr (SP2) {
        PG8_STAGE(PG8_SB(0, 0), cB, voffB); PG8_STAGE(PG8_SB(0, 1), cB + hstepB, voffB); PG8_STAGE(PG8_SA(0, 0), cA, voffA); PG8_STAGE(PG8_SA(0, 1), cA + hstepA, voffA);
        if (wr == 1) PG8_BAR;
        PG8_WAIT_V(2); PG8_BAR;
        PG8_STAGE(PG8_SB(1, 0), cB + kstep, voffB); PG8_STAGE(PG8_SA(1, 0), cA + kstep, voffA); PG8_STAGE(PG8_SB(1, 1), cB + hstepB + kstep, voffB);
        PG8_WAIT_V(6); PG8_BAR;
    } else {
        PG8_STAGE(PG8_SB(0, 0), cB, voffB); PG8_STAGE(PG8_SA(0, 0), cA, voffA); PG8_STAGE(PG8_SB(0, 1), cB + hstepB, voffB); PG8_STAGE(PG8_SA(0, 1), cA + hstepA, voffA);
        if (wr == 1) PG8_BAR;
        PG8_WAIT_V(4); PG8_BAR;
        PG8_STAGE(PG8_SB(1, 0), cB + kstep, voffB); PG8_STAGE(PG8_SA(1, 0), cA + kstep, voffA); PG8_STAGE(PG8_SB(1, 1), cB + hstepB + kstep, voffB);
        PG8_WAIT_V(6); PG8_BAR;
    }
    for (;;) {
        const bool has_next = S.next(ui + 1, nxt);
        const char* nA = has_next ? (const char*)g.A + (size_t)nxt.pm * tstepA : cA; const char* nB = has_next ? (const char*)g.Bt + (size_t)nxt.pn * tstepB : cB;
        int tb_ = 0;
#pragma unroll 1
        for (int seg = 0; seg < (Epi::MID ? 3 : 1); ++seg) {
        const int te_ = Epi::MID ? (seg == 0 ? Epi::MID_T1 : (seg == 1 ? Epi::MID_T2 : nt)) : nt;
#pragma unroll 1
        for (int t = tb_; t < te_; t += 2) {
            const bool last = (t == nt - 2);
            const char* a1 = cA + (size_t)(t + 1) * kstep;
            const char* a2 = last ? nA : cA + (size_t)(t + 2) * kstep; const char* b2 = last ? nB : cB + (size_t)(t + 2) * kstep;
            const char* a3 = a2 + kstep; const char* b3 = b2 + kstep;
            if (last && has_next) S.a_ready(nxt);
            if constexpr (SP2) {
            PG8_LDB(B0, 0, 0); PG8_LDB(B1, 0, 1); PG8_SCHED; PG8_LDA(At, 0, 0); PG8_STAGE(PG8_SA(1, 1), a1 + hstepA, voffA);
            PG8_WAIT_V(8); PG8_WAIT_L(0); PG8_BAR; PG8_MMA(0, 0, At, B0); PG8_MMA(0, 1, At, B1); PG8_BAR; PG8_SCHED;
            PG8_LDA(At, 0, 1); PG8_STAGE(PG8_SB(0, 0), b2, voffB); PG8_STAGE(PG8_SB(0, 1), b2 + hstepB, voffB); PG8_STAGE(PG8_SA(0, 0), a2, voffA);
            PG8_WAIT_V(8); PG8_WAIT_L(0); PG8_BAR; PG8_MMA(1, 0, At, B0); PG8_MMA(1, 1, At, B1); PG8_BAR; PG8_SCHED;
            PG8_LDB(B0, 1, 0); PG8_LDB(B1, 1, 1); PG8_SCHED; PG8_LDA(At, 1, 0); PG8_STAGE(PG8_SA(0, 1), a2 + hstepA, voffA);
            PG8_WAIT_V(8); PG8_WAIT_L(0); PG8_BAR; PG8_MMA(0, 0, At, B0); PG8_MMA(0, 1, At, B1); PG8_BAR; PG8_SCHED;
            PG8_LDA(At, 1, 1); PG8_STAGE(PG8_SB(1, 0), b3, voffB); PG8_STAGE(PG8_SB(1, 1), b3 + hstepB, voffB); PG8_STAGE(PG8_SA(1, 0), a3, voffA);
            PG8_WAIT_V(8); PG8_WAIT_L(0); PG8_BAR; PG8_MMA(1, 0, At, B0); PG8_MMA(1, 1, At, B1); PG8_BAR; PG8_SCHED;
            } else {
            PG8_LDB(B0, 0, 0); PG8_SCHED; PG8_LDA(At, 0, 0); PG8_STAGE(PG8_SA(1, 1), a1 + hstepA, voffA);
            PG8_WAIT_L(8); PG8_BAR; PG8_WAIT_L(0); PG8_MMA(0, 0, At, B0); PG8_BAR; PG8_SCHED;
            PG8_LDB(B1, 0, 1); PG8_STAGE(PG8_SB(0, 0), b2, voffB);
            PG8_BAR; PG8_WAIT_L(0); PG8_MMA(0, 1, At, B1); PG8_BAR;
            PG8_LDA(At, 0, 1); PG8_STAGE(PG8_SA(0, 0), a2, voffA);
            PG8_BAR; PG8_WAIT_L(0); PG8_MMA(1, 0, At, B0); PG8_BAR; PG8_SCHED;
            PG8_STAGE(PG8_SB(0, 1), b2 + hstepB, voffB);
            PG8_WAIT_V(6); PG8_BAR; PG8_MMA(1, 1, At, B1); PG8_BAR;
            PG8_LDB(B0, 1, 0); PG8_SCHED; PG8_LDA(At, 1, 0); PG8_STAGE(PG8_SA(0, 1), a2 + hstepA, voffA);
            PG8_WAIT_L(8); PG8_BAR; PG8_WAIT_L(0); PG8_MMA(0, 0, At, B0); PG8_BAR; PG8_SCHED;
            PG8_LDB(B1, 1, 1); PG8_STAGE(PG8_SB(1, 0), b3, voffB);
            PG8_BAR; PG8_WAIT_L(0); PG8_MMA(0, 1, At, B1); PG8_BAR;
            PG8_LDA(At, 1, 1); PG8_STAGE(PG8_SA(1, 0), a3, voffA);
            PG8_BAR; PG8_WAIT_L(0); PG8_MMA(1, 0, At, B0); PG8_BAR; PG8_SCHED;
            PG8_STAGE(PG8_SB(1, 1), b3 + hstepB, voffB);
            PG8_WAIT_V(6); PG8_BAR; PG8_MMA(1, 1, At, B1); PG8_BAR;
            }
        }
        if constexpr (Epi::MID) { if (seg < 2) { if constexpr (F8) asm volatile("s_nop 15\n\ts_nop 7" ::: "memory"); E.mid(acc, cur, wr, wc, fr, fq, seg); } }
        tb_ = te_;
        }
        if constexpr (ALIGN_EPI) { if (wr == 0) PG8_BAR; }
        if constexpr (F8) asm volatile("s_nop 15\n\ts_nop 7" ::: "memory");
        if constexpr (!Epi::AFTER_DRAIN) { E(acc, cur, wr, wc, fr, fq); S.done(cur); }
        if (!has_next) break;
#pragma unroll
        for (int a = 0; a < 2; ++a)
#pragma unroll
            for (int b = 0; b < 2; ++b)
#pragma unroll
                for (int m = 0; m < 4; ++m)
#pragma unroll
                    for (int n = 0; n < 2; ++n) acc[a][b][m][n] = (f32x4){0.f, 0.f, 0.f, 0.f};
        cur = nxt; cA = nA; cB = nB; ++ui;
        if constexpr (ALIGN_EPI) { if (wr == 1) PG8_BAR; }
    }
    PG8_WAIT_V(0);
    if constexpr (!ALIGN_EPI) { if (wr == 0) PG8_BAR; }
    PG8_BAR;
    if constexpr (Epi::AFTER_DRAIN) { E.fused(acc, cur, wr, wc, fr, fq, lds); S.done(cur); }
#undef PG8_SA
#undef PG8_SB
#undef PG8_STAGE
#undef PG8_LDA
#undef PG8_LDB
#undef PG8_MMA
#undef PG8_WAIT_V
#undef PG8_WAIT_L
#undef PG8_BAR
#undef PG8_SCHED
}
}
#ifndef PG8_SP2
#define PG8_SP2 true
#endif
#ifndef PG8_ALIGN
#define PG8_ALIGN true
#endif
using pg8::Unit;

struct EpiZ {
    static constexpr bool PERM = true, WIDE = true, MID = false, AFTER_DRAIN = false; static constexpr int MID_T1 = -1, MID_T2 = -1;
    __device__ __forceinline__ void pre(f32x4 (&)[2][2][4][2], const Unit&, int, int, int, int, int) const {}
    bf16_t* Z; const float* rope; const float* lg2g; int seg; unsigned char* zm8;
    __device__ __forceinline__ void mid(f32x4 (&)[2][2][4][2], const Unit&, int, int, int, int, int) const {}
    __device__ __forceinline__ void operator()(const f32x4 (&acc)[2][2][4][2], const Unit& u, int wr, int wc, int fr, int fq) const {
        const int pn = (seg == 1) ? (u.pn < 24 ? u.pn + 8 : u.pn + 24) : (u.pn < 8 ? u.pn : (u.pn < 24 ? u.pn + 24 : u.pn + 32));
        const int row0 = u.pm * 256 + wr * 64 + fr, col0 = pn * 256 + wc * 64 + 8 * fq;
        GAS bf16_t* zb = opqg(Z + (size_t)row0 * ZLD + col0); const GAS unsigned* ropeb = opqg((const unsigned*)rope + (32 * (wc & 1) + 4 * fq));
        int mode;
        float sc = 1.f;
        if (pn < 8) mode = 3; else if (pn < 16) mode = 4; else if (pn < 32) mode = 0; else if (pn < 48) mode = 1; else if (pn < 56) mode = 0; else if (pn < 64) mode = 1;
        else if (pn < 72) { mode = 0; sc = 0.04419417382415922f; } else if (pn < 80) mode = 1; else mode = 2;
        if (mode >= 3) {
            const float ksc = (mode == 4) ? 0.08838834764831845f : 1.0f; const float sgn = (mode == 4) ? -1.0f : 1.0f;
            const int h = (2 * pn + (wc >> 1)) & 15;
            u32x4 rw[16];
#pragma unroll
            for (int ai = 0; ai < 2; ++ai)
#pragma unroll
                for (int m = 0; m < 4; ++m) { const int row = row0 + ai * 128 + m * 16; const int prow = row < TP ? (row & 2047) : 2048 + (row & 7);
                    const GAS u32x4* rp = (const GAS u32x4*)(ropeb + (size_t)prow * 64);
                    rw[(ai * 4 + m) * 2] = rp[0]; rw[(ai * 4 + m) * 2 + 1] = rp[4]; }
#pragma unroll
            for (int ai = 0; ai < 2; ++ai)
#pragma unroll
                for (int m = 0; m < 4; ++m) {
                    const int row = row0 + ai * 128 + m * 16;
                    const float ip1 = (float)((row < TP ? (row & 63) : (row & 7)) + 1);
                    const float f = exp2f(sgn * lg2g[h] * ip1) * ksc;
                    GAS bf16_t* rowp = zb + (size_t)(ai * 128 + m * 16) * ZLD;
#pragma unroll
                    for (int bj = 0; bj < 2; ++bj) {
                        const u32x4 w4 = rw[(ai * 4 + m) * 2 + bj];
                        const f32x4 r0 = {__uint_as_float(w4.x << 16), __uint_as_float(w4.x & 0xffff0000u), __uint_as_float(w4.y << 16), __uint_as_float(w4.y & 0xffff0000u)};
                        const f32x4 r1 = {__uint_as_float(w4.z << 16), __uint_as_float(w4.z & 0xffff0000u), __uint_as_float(w4.w << 16), __uint_as_float(w4.w & 0xffff0000u)};
                        const f32x4 v0 = acc[ai][bj][m][0], v1 = acc[ai][bj][m][1];
                        float o0 = (v0[0] * r0[0] - v0[1] * r0[1]) * f, o1 = (v0[0] * r0[1] + v0[1] * r0[0]) * f;
                        float o2 = (v0[2] * r0[2] - v0[3] * r0[3]) * f, o3 = (v0[2] * r0[3] + v0[3] * r0[2]) * f;
                        float o4 = (v1[0] * r1[0] - v1[1] * r1[1]) * f, o5 = (v1[0] * r1[1] + v1[1] * r1[0]) * f;
                        float o6 = (v1[2] * r1[2] - v1[3] * r1[3]) * f, o7 = (v1[2] * r1[3] + v1[3] * r1[2]) * f;
                        u32x4 w; w.x = cvt_pk_bf16(o0, o1); w.y = cvt_pk_bf16(o2, o3); w.z = cvt_pk_bf16(o4, o5); w.w = cvt_pk_bf16(o6, o7);
                        __builtin_nontemporal_store(w, (GAS u32x4*)(rowp + bj * 32));
                    }
                }
        } else {
#pragma unroll
            for (int ai = 0; ai < 2; ++ai)
#pragma unroll
                for (int m = 0; m < 4; ++m) {
                    GAS bf16_t* rowp = zb + (size_t)(ai * 128 + m * 16) * ZLD;
#pragma unroll
                    for (int bj = 0; bj < 2; ++bj) {
                        f32x4 v0 = acc[ai][bj][m][0], v1 = acc[ai][bj][m][1];
                        if (mode == 0) { v0 = v0 * sc; v1 = v1 * sc; }
                        else if (mode == 1) {
#pragma unroll
                            for (int j = 0; j < 4; ++j) { v0[j] = silu_f(v0[j]); v1[j] = silu_f(v1[j]); }
                            const int G = pn < 48 ? ZGR : (pn < 64 ? ZGS : ZGX);
                            *(u32x2*)((unsigned char*)(Z + (size_t)(row0 + ai * 128 + m * 16) * ZLD + G) + (pn * 256 - G) + wc * 64 + 8 * fq + bj * 32) = pk8_fp8(v0, v1, GSC); continue;
                        } else {
#pragma unroll
                            for (int j = 0; j < 4; ++j) { v0[j] = fmaxf(sigmoid_f(v0[j]) * 255.f, 1.f); v1[j] = fmaxf(sigmoid_f(v1[j]) * 255.f, 1.f); }
                            u32x2 g8; g8.x = pk4_u8(v0[0], v0[1], v0[2], v0[3]); g8.y = pk4_u8(v1[0], v1[1], v1[2], v1[3]);
                            *(u32x2*)(zm8 + (size_t)(row0 + ai * 128 + m * 16) * LDM8 + (col0 - ZMA) + bj * 32) = g8; continue;
                        }
                        u32x4 w; w.x = cvt_pk_bf16(v0[0], v0[1]); w.y = cvt_pk_bf16(v0[2], v0[3]); w.z = cvt_pk_bf16(v1[0], v1[1]); w.w = cvt_pk_bf16(v1[2], v1[3]);
                        __builtin_nontemporal_store(w, (GAS u32x4*)(rowp + bj * 32));
                    }
                }
        }
    }
};
struct EpiKV {
    static constexpr bool PERM = false, WIDE = false, MID = false, AFTER_DRAIN = false; static constexpr int MID_T1 = -1, MID_T2 = -1;
    __device__ __forceinline__ void pre(f32x4 (&)[2][2][4][2], const Unit&, int, int, int, int, int) const {}
    float* mk; float* mv; bf16_t* kvb;
    __device__ __forceinline__ void mid(f32x4 (&)[2][2][4][2], const Unit&, int, int, int, int, int) const {}
    __device__ __forceinline__ void operator()(const f32x4 (&acc)[2][2][4][2], const Unit& u, int wr, int wc, int fr, int fq) const {
        const int row0 = u.pm * 256 + wr * 64 + fr, col0 = u.pn * 256 + wc * 32 + 4 * fq;
        float* dst = (col0 < 2048) ? mk : mv; const int cc0 = col0 & 2047;
#pragma unroll
        for (int ai = 0; ai < 2; ++ai)
#pragma unroll
            for (int m = 0; m < 4; ++m) { const int row = row0 + ai * 128 + m * 16;
#pragma unroll
                for (int bj = 0; bj < 2; ++bj)
#pragma unroll
                    for (int n = 0; n < 2; ++n) { const f32x4 v = acc[ai][bj][m][n]; const int co = bj * 128 + n * 16;
                        *(f32x4*)(dst + (size_t)row * 2048 + cc0 + co) = v;
                        u32x2 w; w.x = cvt_pk_bf16(v[0], v[1]); w.y = cvt_pk_bf16(v[2], v[3]);
                        *(u32x2*)(kvb + (size_t)row * 4096 + col0 + co) = w; } }
    }
    __device__ __forceinline__ void quarter(const f32x4 (&q)[2][2][2], const Unit& u, int wr, int wc, int fr, int fq, int ai, int mh) const {
        const int row0 = u.pm * 256 + wr * 64 + fr + ai * 128 + mh * 32, col0 = u.pn * 256 + wc * 32 + 4 * fq;
        float* dst = (col0 < 2048) ? mk : mv; const int cc0 = col0 & 2047;
#pragma unroll
        for (int mm = 0; mm < 2; ++mm) { const int row = row0 + mm * 16;
#pragma unroll
            for (int bj = 0; bj < 2; ++bj)
#pragma unroll
                for (int n = 0; n < 2; ++n) { const f32x4 v = q[bj][mm][n]; const int co = bj * 128 + n * 16;
                    *(f32x4*)(dst + (size_t)row * 2048 + cc0 + co) = v;
                    u32x2 w; w.x = cvt_pk_bf16(v[0], v[1]); w.y = cvt_pk_bf16(v[2], v[3]);
                    *(u32x2*)(kvb + (size_t)row * 4096 + col0 + co) = w; } }
    }
};
struct EpiGlu {
    static constexpr bool PERM = true, WIDE = false, MID = false, AFTER_DRAIN = false; static constexpr int MID_T1 = -1, MID_T2 = -1;
    __device__ __forceinline__ void pre(f32x4 (&)[2][2][4][2], const Unit&, int, int, int, int, int) const {}
    const bf16_t* Z; unsigned char* acat;
    __device__ __forceinline__ void mid(f32x4 (&)[2][2][4][2], const Unit&, int, int, int, int, int) const {}
    __device__ __forceinline__ void operator()(const f32x4 (&acc)[2][2][4][2], const Unit& u, int wr, int wc, int fr, int fq) const {
        const int row0 = u.pm * 256 + wr * 64 + fr, col0 = u.pn * 128 + wc * 32 + 8 * fq;
        u32x2 gpre[8];
#pragma unroll
        for (int i = 0; i < 8; ++i) gpre[i] = *(const u32x2*)gate8(Z, (size_t)(row0 + (i >> 2) * 128 + (i & 3) * 16), ZGS, col0);
#pragma unroll
        for (int ai = 0; ai < 2; ++ai)
#pragma unroll
            for (int m = 0; m < 4; ++m) { const int row = row0 + ai * 128 + m * 16;
                float gs8[8]; unpack8_fp8(gpre[ai * 4 + m], gs8);
                float o[8];
#pragma unroll
                for (int n = 0; n < 2; ++n)
#pragma unroll
                    for (int j = 0; j < 4; ++j) o[n * 4 + j] = acc[ai][0][m][n][j] * sigmoid_f(acc[ai][1][m][n][j]) * gs8[n * 4 + j] * (ACS / GSC);
                u32x2 w; w.x = pk4_fp8(o[0], o[1], o[2], o[3]); w.y = pk4_fp8(o[4], o[5], o[6], o[7]);
                *(u32x2*)(acat + (size_t)row * LDA8 + AC_S5 + col0) = w; }
    }
    __device__ __forceinline__ void quarter(const f32x4 (&q)[2][2][2], const Unit& u, int wr, int wc, int fr, int fq, int ai, int mh) const {
        const int row0 = u.pm * 256 + wr * 64 + fr + ai * 128 + mh * 32, col0 = u.pn * 128 + wc * 32 + 8 * fq;
#pragma unroll
        for (int mm = 0; mm < 2; ++mm) { const int row = row0 + mm * 16;
            float gs8[8]; unpack8_fp8(*(const u32x2*)gate8(Z, (size_t)row, ZGS, col0), gs8);
            float o[8];
#pragma unroll
            for (int n = 0; n < 2; ++n)
#pragma unroll
                for (int j = 0; j < 4; ++j) o[n * 4 + j] = q[0][mm][n][j] * sigmoid_f(q[1][mm][n][j]) * gs8[n * 4 + j] * (ACS / GSC);
            u32x2 w; w.x = pk4_fp8(o[0], o[1], o[2], o[3]); w.y = pk4_fp8(o[4], o[5], o[6], o[7]);
            *(u32x2*)(acat + (size_t)row * LDA8 + AC_S5 + col0) = w; }
    }
};
struct EpiProj {
    static constexpr bool PERM = true, WIDE = true, MID = true, AFTER_DRAIN = false; static constexpr int MID_T1 = 32, MID_T2 = 48;
    __device__ __forceinline__ void pre(f32x4 (&)[2][2][4][2], const Unit&, int, int, int, int, int) const {}
    const unsigned char* zm8; unsigned char* merged;
    __device__ __forceinline__ void mid(f32x4 (&acc)[2][2][4][2], const Unit& u, int wr, int wc, int fr, int fq, int which) const {
        const int row0 = u.pm * 256 + wr * 64 + fr, col0 = u.pn * 256 + wc * 64 + 8 * fq;
        const unsigned char* zb = zm8 + (size_t)row0 * LDM8 + col0 + which * 4096;
        u32x2 ga[16], gb[16];
#pragma unroll
        for (int ai = 0; ai < 2; ++ai)
#pragma unroll
            for (int m = 0; m < 4; ++m) { const unsigned char* zr = zb + (size_t)(ai * 128 + m * 16) * LDM8;
#pragma unroll
                for (int bj = 0; bj < 2; ++bj) { ga[(ai * 4 + m) * 2 + bj] = *(const u32x2*)(zr + bj * 32); gb[(ai * 4 + m) * 2 + bj] = *(const u32x2*)(zr + 4096 + bj * 32); } }
#pragma unroll
        for (int ai = 0; ai < 2; ++ai)
#pragma unroll
            for (int m = 0; m < 4; ++m)
#pragma unroll
                for (int bj = 0; bj < 2; ++bj) { const u32x2 a = ga[(ai * 4 + m) * 2 + bj], b = gb[(ai * 4 + m) * 2 + bj];
#pragma unroll
                    for (int n = 0; n < 2; ++n) {
#pragma unroll
                        for (int j = 0; j < 4; ++j) acc[ai][bj][m][n][j] *= ub(a[n], j) * fast_rcp(ub(b[n], j));
                        asm volatile("" : "+v"(acc[ai][bj][m][n])); } }
    }
    __device__ __forceinline__ void operator()(const f32x4 (&acc)[2][2][4][2], const Unit& u, int wr, int wc, int fr, int fq) const {
        const int row0 = u.pm * 256 + wr * 64 + fr, col0 = u.pn * 256 + wc * 64 + 8 * fq;
        u32x2 gc[16];
#pragma unroll
        for (int ai = 0; ai < 2; ++ai)
#pragma unroll
            for (int m = 0; m < 4; ++m) { const unsigned char* zr = zm8 + (size_t)(row0 + ai * 128 + m * 16) * LDM8 + 2 * 4096 + col0;
#pragma unroll
                for (int bj = 0; bj < 2; ++bj) gc[(ai * 4 + m) * 2 + bj] = *(const u32x2*)(zr + bj * 32); }
#pragma unroll
        for (int ai = 0; ai < 2; ++ai)
#pragma unroll
            for (int m = 0; m < 4; ++m) { const int row = row0 + ai * 128 + m * 16;
#pragma unroll
                for (int bj = 0; bj < 2; ++bj) { const u32x2 c = gc[(ai * 4 + m) * 2 + bj]; f32x4 o0, o1;
#pragma unroll
                    for (int j = 0; j < 4; ++j) { o0[j] = acc[ai][bj][m][0][j] * ub(c.x, j); o1[j] = acc[ai][bj][m][1][j] * ub(c.y, j); }
                    *(u32x2*)(merged + (size_t)row * LD8 + col0 + bj * 32) = pk8_fp8(o0, o1, 16.f / 255.f); } }
    }
};
struct EpiOut {
    static constexpr bool PERM = true, WIDE = true, MID = false, AFTER_DRAIN = false; static constexpr int MID_T1 = -1, MID_T2 = -1;
    __device__ __forceinline__ void pre(f32x4 (&)[2][2][4][2], const Unit&, int, int, int, int, int) const {}
    const bf16_t* xbf; bf16_t* vb;
    __device__ __forceinline__ void mid(f32x4 (&)[2][2][4][2], const Unit&, int, int, int, int, int) const {}
    __device__ __forceinline__ void operator()(const f32x4 (&acc)[2][2][4][2], const Unit& u, int wr, int wc, int fr, int fq) const {
        const int row0 = u.pm * 256 + wr * 64 + fr, col0 = u.pn * 256 + wc * 64 + 8 * fq;
        u32x4 xw16[16];
#pragma unroll
        for (int ai = 0; ai < 2; ++ai)
#pragma unroll
            for (int m = 0; m < 4; ++m) { const bf16_t* xr = xbf + (size_t)(row0 + ai * 128 + m * 16) * LDX + col0;
#pragma unroll
                for (int bj = 0; bj < 2; ++bj) xw16[(ai * 4 + m) * 2 + bj] = *(const u32x4*)(xr + bj * 32); }
#pragma unroll
        for (int ai = 0; ai < 2; ++ai)
#pragma unroll
            for (int m = 0; m < 4; ++m) { const int row = row0 + ai * 128 + m * 16;
#pragma unroll
                for (int bj = 0; bj < 2; ++bj) { const u32x4 xw = xw16[(ai * 4 + m) * 2 + bj];
                    const f32x4 x0 = {__uint_as_float(xw.x << 16), __uint_as_float(xw.x & 0xffff0000u), __uint_as_float(xw.y << 16), __uint_as_float(xw.y & 0xffff0000u)}, x1 = {__uint_as_float(xw.z << 16), __uint_as_float(xw.z & 0xffff0000u), __uint_as_float(xw.w << 16), __uint_as_float(xw.w & 0xffff0000u)};
                    const f32x4 v0 = x0 * DN_ALPHA + acc[ai][bj][m][0], v1 = x1 * DN_ALPHA + acc[ai][bj][m][1];
                    u32x4 w; w.x = cvt_pk_bf16(v0[0], v0[1]); w.y = cvt_pk_bf16(v0[2], v0[3]); w.z = cvt_pk_bf16(v1[0], v1[1]); w.w = cvt_pk_bf16(v1[2], v1[3]);
                    *(u32x4*)(vb + (size_t)row * ALD + col0 + bj * 32) = w; } }
    }
    __device__ __forceinline__ void quarter(const f32x4 (&q)[2][2][2], const Unit& u, int wr, int wc, int fr, int fq, int ai, int mh) const {
        const int row0 = u.pm * 256 + wr * 64 + fr + ai * 128 + mh * 32, col0 = u.pn * 256 + wc * 64 + 8 * fq;
#pragma unroll
        for (int mm = 0; mm < 2; ++mm) { const int row = row0 + mm * 16; const bf16_t* xr = xbf + (size_t)row * LDX + col0;
#pragma unroll
            for (int bj = 0; bj < 2; ++bj) { const u32x4 xw = *(const u32x4*)(xr + bj * 32);
                    const f32x4 x0 = {__uint_as_float(xw.x << 16), __uint_as_float(xw.x & 0xffff0000u), __uint_as_float(xw.y << 16), __uint_as_float(xw.y & 0xffff0000u)}, x1 = {__uint_as_float(xw.z << 16), __uint_as_float(xw.z & 0xffff0000u), __uint_as_float(xw.w << 16), __uint_as_float(xw.w & 0xffff0000u)};
                const f32x4 v0 = x0 * DN_ALPHA + q[bj][mm][0], v1 = x1 * DN_ALPHA + q[bj][mm][1];
                u32x4 w; w.x = cvt_pk_bf16(v0[0], v0[1]); w.y = cvt_pk_bf16(v0[2], v0[3]); w.z = cvt_pk_bf16(v1[0], v1[1]); w.w = cvt_pk_bf16(v1[2], v1[3]);
                *(u32x4*)(vb + (size_t)row * ALD + col0 + bj * 32) = w; } }
    }
};
struct EpiProjQ {
    static constexpr bool PERM = true, WIDE = true, MID = false, AFTER_DRAIN = false; static constexpr int MID_T1 = -1, MID_T2 = -1;
    const unsigned char* zm8; unsigned char* merged;
    __device__ __forceinline__ void mid(f32x4 (&)[2][2][4][2], const Unit&, int, int, int, int, int) const {}
    __device__ __forceinline__ void pre(f32x4 (&acc)[2][2][4][2], const Unit& u, int wr, int wc, int fr, int fq, int kq) const {
        const int row0 = u.pm * 256 + wr * 64 + fr, col0 = u.pn * 256 + wc * 64 + 8 * fq;
        const unsigned char* zb = zm8 + (size_t)row0 * LDM8 + col0 + (kq < 2 ? 0 : kq - 1) * 4096;
        u32x2 gpre[16];
#pragma unroll
        for (int i = 0; i < 16; ++i) gpre[i] = *(const u32x2*)(zb + (size_t)((i >> 3) * 128 + ((i >> 1) & 3) * 16) * LDM8 + (i & 1) * 32);
#pragma unroll
        for (int ai = 0; ai < 2; ++ai)
#pragma unroll
            for (int m = 0; m < 4; ++m) {
#pragma unroll
                for (int bj = 0; bj < 2; ++bj) { const u32x2 c = gpre[(ai * 4 + m) * 2 + bj];
#pragma unroll
                    for (int n = 0; n < 2; ++n) {
#pragma unroll
                        for (int j = 0; j < 4; ++j) acc[ai][bj][m][n][j] *= ub(c[n], j) * (1.f / 255.f);
                        asm volatile("" : "+v"(acc[ai][bj][m][n])); } } }
    }
    __device__ __forceinline__ void operator()(const f32x4 (&acc)[2][2][4][2], const Unit& u, int wr, int wc, int fr, int fq) const {
        const int row0 = u.pm * 256 + wr * 64 + fr, col0 = u.pn * 256 + wc * 64 + 8 * fq;
#pragma unroll
        for (int ai = 0; ai < 2; ++ai)
#pragma unroll
            for (int m = 0; m < 4; ++m) { const int row = row0 + ai * 128 + m * 16;
#pragma unroll
                for (int bj = 0; bj < 2; ++bj) *(u32x2*)(merged + (size_t)row * LD8 + col0 + bj * 32) = pk8_fp8(acc[ai][bj][m][0], acc[ai][bj][m][1], 16.f); }
    }
    __device__ __forceinline__ void quarter(const f32x4 (&q)[2][2][2], const Unit& u, int wr, int wc, int fr, int fq, int ai, int mh) const {
        const int row0 = u.pm * 256 + wr * 64 + fr + ai * 128 + mh * 32, col0 = u.pn * 256 + wc * 64 + 8 * fq;
#pragma unroll
        for (int mm = 0; mm < 2; ++mm) { const int row = row0 + mm * 16;
#pragma unroll
            for (int bj = 0; bj < 2; ++bj) *(u32x2*)(merged + (size_t)row * LD8 + col0 + bj * 32) = pk8_fp8(q[bj][mm][0], q[bj][mm][1], 16.f); }
    }
};
constexpr int SLAB_BYTES = 262144;
template <class Inner, int NS = 4, bool DEFER = false> struct EpiSplit {
    static constexpr bool PERM = Inner::PERM, WIDE = Inner::WIDE, MID = false, AFTER_DRAIN = true; static constexpr int MID_T1 = -1, MID_T2 = -1;
    static constexpr bool BF = true; static constexpr int SLB = BF ? SLAB_BYTES / 2 : SLAB_BYTES;
    Inner inner; unsigned char* slab; unsigned* ticket; int kq;
    __device__ __forceinline__ void mid(f32x4 (&)[2][2][4][2], const Unit&, int, int, int, int, int) const {}
    __device__ __forceinline__ void operator()(const f32x4 (&)[2][2][4][2], const Unit&, int, int, int, int) const {}
    __device__ __forceinline__ void fused(f32x4 (&acc)[2][2][4][2], const Unit& u, int wr, int wc, int fr, int fq, LAS unsigned char* lds) const {
        inner.pre(acc, u, wr, wc, fr, fq, kq);
        const __amdgpu_buffer_rsrc_t rs = __builtin_amdgcn_make_buffer_rsrc((void*)slab, (short)0, NS * SLB, 0x00020000);
        const int tid = threadIdx.x; const int off = kq * SLB + tid * 16;
#pragma unroll
        for (int a = 0; a < 2; ++a)
#pragma unroll
            for (int b = 0; b < 2; ++b)
#pragma unroll
                for (int m = 0; m < 4; ++m) {
                    if constexpr (BF) { const f32x4 v0 = acc[a][b][m][0], v1 = acc[a][b][m][1]; u32x4 w; w.x = cvt_pk_bf16(v0[0], v0[1]); w.y = cvt_pk_bf16(v0[2], v0[3]); w.z = cvt_pk_bf16(v1[0], v1[1]); w.w = cvt_pk_bf16(v1[2], v1[3]);
                        __builtin_amdgcn_raw_buffer_store_b128(w, rs, off + ((a * 2 + b) * 4 + m) * 8192, 0, 16); }
                    else {
#pragma unroll
                        for (int n = 0; n < 2; ++n) __builtin_amdgcn_raw_buffer_store_b128(__builtin_bit_cast(u32x4, acc[a][b][m][n]), rs, off + (((a * 2 + b) * 4 + m) * 2 + n) * 8192, 0, 16); } }
        if constexpr (!DEFER) join(u, wr, wc, fr, fq);
    }
    __device__ __forceinline__ void finish(const Unit& u) const {
        const int tid = threadIdx.x, wid = tid >> 6, lane = tid & 63; join(u, wid >> 2, wid & 3, lane & 15, lane >> 4);
    }
    __device__ __forceinline__ void join(const Unit& u, int wr, int wc, int fr, int fq) const {
        const __amdgpu_buffer_rsrc_t rs = __builtin_amdgcn_make_buffer_rsrc((void*)slab, (short)0, NS * SLB, 0x00020000);
        const int tid = threadIdx.x;
        asm volatile("s_waitcnt vmcnt(0)" ::: "memory");
        __syncthreads();
        if (tid == 0) { (void)__hip_atomic_fetch_add(ticket, 1u, __ATOMIC_RELAXED, __HIP_MEMORY_SCOPE_AGENT);
            unsigned sp = 0; while (__hip_atomic_load(ticket, __ATOMIC_RELAXED, __HIP_MEMORY_SCOPE_AGENT) < (unsigned)NS) { __builtin_amdgcn_s_sleep(2); if (++sp > (1u << 22)) break; }
            __builtin_amdgcn_fence(__ATOMIC_ACQUIRE, "wavefront"); }
        __syncthreads();
#pragma unroll 1
        for (int part = 0; part < 4 / NS; ++part) {
            const int ai = (NS == 4) ? (kq >> 1) : kq, mh = (NS == 4) ? (kq & 1) : part;
            f32x4 q[2][2][2];
#pragma unroll
            for (int b = 0; b < 2; ++b)
#pragma unroll
                for (int mm = 0; mm < 2; ++mm)
#pragma unroll
                    for (int n = 0; n < 2; ++n) q[b][mm][n] = (f32x4){0.f, 0.f, 0.f, 0.f};
            if constexpr (BF) {
#pragma unroll
                for (int k = 0; k < NS; ++k) { u32x4 t[4];
#pragma unroll
                    for (int b = 0; b < 2; ++b)
#pragma unroll
                        for (int mm = 0; mm < 2; ++mm) t[b * 2 + mm] = __builtin_amdgcn_raw_buffer_load_b128(rs, k * SLB + tid * 16 + (((ai * 2 + b) * 4 + 2 * mh + mm) * 8192), 0, 16);
#pragma unroll
                    for (int b = 0; b < 2; ++b)
#pragma unroll
                        for (int mm = 0; mm < 2; ++mm) { const u32x4 w = t[b * 2 + mm];
                            q[b][mm][0] += (f32x4){__uint_as_float(w.x << 16), __uint_as_float(w.x & 0xffff0000u), __uint_as_float(w.y << 16), __uint_as_float(w.y & 0xffff0000u)};
                            q[b][mm][1] += (f32x4){__uint_as_float(w.z << 16), __uint_as_float(w.z & 0xffff0000u), __uint_as_float(w.w << 16), __uint_as_float(w.w & 0xffff0000u)}; } }
            } else {
#pragma unroll
                for (int k = 0; k < NS; ++k) { u32x4 t[8];
#pragma unroll
                    for (int b = 0; b < 2; ++b)
#pragma unroll
                        for (int mm = 0; mm < 2; ++mm)
#pragma unroll
                            for (int n = 0; n < 2; ++n) t[(b * 2 + mm) * 2 + n] = __builtin_amdgcn_raw_buffer_load_b128(rs, k * SLB + tid * 16 + ((((ai * 2 + b) * 4 + 2 * mh + mm) * 2 + n) * 8192), 0, 16);
#pragma unroll
                    for (int b = 0; b < 2; ++b)
#pragma unroll
                        for (int mm = 0; mm < 2; ++mm)
#pragma unroll
                            for (int n = 0; n < 2; ++n) q[b][mm][n] += __builtin_bit_cast(f32x4, t[(b * 2 + mm) * 2 + n]); }
            }
            inner.quarter(q, u, wr, wc, fr, fq, ai, mh);
        }
    }
};
struct OneUnit {
    Unit u;
    __device__ __forceinline__ bool next(int i, Unit& o) const { o = u; return i == 0; }
    __device__ __forceinline__ void a_ready(const Unit&) const {}
    __device__ __forceinline__ void done(const Unit&) const {}
};
struct Args { const float* in[25]; float* out; unsigned char* ws; int ph_lo, ph_hi; float lg2g[16]; };
struct Ctx {
    const float* const* in; float* out; unsigned char* ws; const float* lg2g;
    bf16_t *XB, *MEMB, *WIN, *WMKV, *WGLU, *WCAT, *WOUT, *Z, *ACAT, *GL, *MERGED, *KVB; float* ROPE; unsigned char* S5T; unsigned char* A8;
    int tid, lane, wave, G, bid;
};

template <int ROWMAP, bool F8OUT = false>
__device__ __forceinline__ void p0_transpose_item(const float* W, int N, bf16_t* WT, int ldk, int koff, LAS float* scr, int kb, int nb, int lane) {
    const int k0 = 64 * kb, n0 = 32 * nb;
#pragma unroll 8
    for (int i = 0; i < 32; ++i) { const int kk = 2 * i + (lane >> 5); scr[kk * 33 + (lane & 31)] = W[(size_t)(k0 + kk) * N + n0 + (lane & 31)]; }
    asm volatile("s_waitcnt lgkmcnt(0)" ::: "memory");
    const int c = lane & 7;
#pragma unroll
    for (int j = 0; j < 4; ++j) { const int n = (lane >> 3) + 8 * j; const LAS float* s = scr + (8 * c) * 33 + n;
        u32x4 o; o.x = cvt_pk_bf16(s[0 * 33], s[1 * 33]); o.y = cvt_pk_bf16(s[2 * 33], s[3 * 33]); o.z = cvt_pk_bf16(s[4 * 33], s[5 * 33]); o.w = cvt_pk_bf16(s[6 * 33], s[7 * 33]);
        int nn = n0 + n;
        if (ROWMAP == 1) { nn = (nn < 2048) ? (256 * (nn >> 7) + (nn & 127)) : (256 * ((nn - 2048) >> 7) + 128 + (nn & 127)); }
        if constexpr (F8OUT) { const f32x4 lo = {s[0 * 33], s[1 * 33], s[2 * 33], s[3 * 33]}, hi = {s[4 * 33], s[5 * 33], s[6 * 33], s[7 * 33]};
            *(u32x2*)((unsigned char*)WT + (size_t)nn * ldk + koff + k0 + 8 * c) = pk8_fp8(lo, hi, 128.f); }
        else *(u32x4*)(WT + (size_t)nn * ldk + koff + k0 + 8 * c) = o; }
    asm volatile("s_waitcnt lgkmcnt(0)" ::: "memory");
}
__device__ __forceinline__ void p0_win_item(const float* W, bf16_t* WB, unsigned char* W8, LAS float* scr, int kb, int nb, int lane) {
    const int k0 = 64 * kb, n0 = 32 * nb, N = 32768;
#pragma unroll 8
    for (int i = 0; i < 32; ++i) { const int kk = 2 * i + (lane >> 5); scr[kk * 33 + (lane & 31)] = W[(size_t)(k0 + kk) * N + n0 + (lane & 31)]; }
    asm volatile("s_waitcnt lgkmcnt(0)" ::: "memory");
    const int c = lane & 7, tile = n0 >> 8;
    const bool isb = (tile >= 8 && tile < 32) || (tile >= 48 && tile < 56);
    const int ct = isb ? (tile < 32 ? tile - 8 : tile - 24) : (tile < 8 ? tile : (tile < 48 ? tile - 24 : tile - 32));
#pragma unroll
    for (int j = 0; j < 4; ++j) { const int n = (lane >> 3) + 8 * j; const LAS float* sp = scr + (8 * c) * 33 + n; const int row = ct * 256 + ((n0 + n) & 255);
        if (isb) { u32x4 o; o.x = cvt_pk_bf16(sp[0 * 33], sp[1 * 33]); o.y = cvt_pk_bf16(sp[2 * 33], sp[3 * 33]); o.z = cvt_pk_bf16(sp[4 * 33], sp[5 * 33]); o.w = cvt_pk_bf16(sp[6 * 33], sp[7 * 33]);
            *(u32x4*)(WB + (size_t)row * LDX + k0 + 8 * c) = o; }
        else { unsigned w0 = 0u, w1 = 0u;
            w0 = __builtin_amdgcn_cvt_pk_fp8_f32(sp[0 * 33] * 128.f, sp[1 * 33] * 128.f, w0, false); w0 = __builtin_amdgcn_cvt_pk_fp8_f32(sp[2 * 33] * 128.f, sp[3 * 33] * 128.f, w0, true);
            w1 = __builtin_amdgcn_cvt_pk_fp8_f32(sp[4 * 33] * 128.f, sp[5 * 33] * 128.f, w1, false); w1 = __builtin_amdgcn_cvt_pk_fp8_f32(sp[6 * 33] * 128.f, sp[7 * 33] * 128.f, w1, true);
            u32x2 o; o.x = w0; o.y = w1; *(u32x2*)(W8 + (size_t)row * LD8 + k0 + 8 * c) = o; } }
    asm volatile("s_waitcnt lgkmcnt(0)" ::: "memory");
}
__device__ __forceinline__ void cvt_rows_x(const float* src, bf16_t* dst, unsigned char* dst8, size_t n4, size_t gtid, size_t gthreads) {
    for (size_t i = gtid; i < n4; i += gthreads) { const f32x4 v = ((const f32x4*)src)[i]; u32x2 w; w.x = cvt_pk_bf16(v[0], v[1]); w.y = cvt_pk_bf16(v[2], v[3]);
        *(u32x2*)(dst + (i >> 10) * LDX + 4 * (i & 1023)) = w;
        unsigned q = 0u; q = __builtin_amdgcn_cvt_pk_fp8_f32(v[0], v[1], q, false); q = __builtin_amdgcn_cvt_pk_fp8_f32(v[2], v[3], q, true);
        *(unsigned*)(dst8 + (i >> 10) * LD8 + 4 * (i & 1023)) = q; }
}
__device__ __forceinline__ void cvt_rows(const float* src, bf16_t* dst, size_t n4, size_t gtid, size_t gthreads) {
    for (size_t i = gtid; i < n4; i += gthreads) { const f32x4 v = ((const f32x4*)src)[i]; u32x2 w; w.x = cvt_pk_bf16(v[0], v[1]); w.y = cvt_pk_bf16(v[2], v[3]);
        *(u32x2*)(dst + (i >> 10) * LDX + 4 * (i & 1023)) = w; }
}
__device__ __forceinline__ void p0_prologue(const Ctx& C, LAS unsigned char* lds) {
    LAS float* scr = (LAS float*)(lds + C.wave * 16384);
    const int gw = C.bid * 8 + C.wave, NGW = C.G * 8;
    constexpr int I_IN = 64 * 1024, I_MKV = 64 * 128, I_GLU = 32 * 128, I_PA = 64 * 128, I_PB = 32 * 128, I_PC = 32 * 128, I_OUT = 64 * 128;
    constexpr int NITEMS = I_IN + I_MKV + I_GLU + I_PA + I_PB + I_PC + I_OUT;
    for (int it = gw; it < NITEMS; it += NGW) {
        int r = it;
        if (r < I_IN) { p0_win_item(C.in[8], C.WIN, C.ws + WS_WIN8, scr, r / 1024, r % 1024, C.lane); continue; } r -= I_IN;
        if (r < I_MKV) { p0_transpose_item<0>(C.in[9], 4096, C.WMKV, LDX, 0, scr, r / 128, r % 128, C.lane); continue; } r -= I_MKV;
        if (r < I_GLU) { p0_transpose_item<1, true>(C.in[18], 4096, C.WGLU, LDG8, 0, scr, r / 128, r % 128, C.lane); continue; } r -= I_GLU;
        if (r < I_PA) { p0_transpose_item<0, true>(C.in[19], 4096, C.WCAT, LDA8, 0, scr, r / 128, r % 128, C.lane); continue; } r -= I_PA;
        if (r < I_PB) { p0_transpose_item<0, true>(C.in[20], 4096, C.WCAT, LDA8, 4096, scr, r / 128, r % 128, C.lane); continue; } r -= I_PB;
        if (r < I_PC) { p0_transpose_item<0, true>(C.in[21], 4096, C.WCAT, LDA8, 6144, scr, r / 128, r % 128, C.lane); continue; } r -= I_PC;
        p0_transpose_item<0, true>(C.in[22], 4096, C.WOUT, LD8, 0, scr, r / 128, r % 128, C.lane);
    }
    const size_t gtid = (size_t)C.bid * 512 + C.tid, gth = (size_t)C.G * 512;
    cvt_rows_x(C.in[0], C.XB, C.ws + WS_XB8, (size_t)TP * DM / 4, gtid, gth);
    cvt_rows_x(C.in[1], C.XB + (size_t)TP * LDX, C.ws + WS_XB8 + (size_t)TP * LD8, (size_t)TS * DM / 4, gtid, gth);
    cvt_rows(C.in[2], C.MEMB, (size_t)1024 * DM / 4, gtid, gth);
    for (size_t e = gtid; e < (size_t)2056 * 64; e += gth) {
        const int prow = (int)(e >> 6), ip = (int)(e & 63); const int pos = prow < 2048 ? prow : 16384 + (prow - 2048);
        const float inv = exp2f(-(float)ip * (13.287712379549449f / 64.f)); const float ang = (float)pos * inv;
        ((unsigned*)C.ROPE)[e] = cvt_pk_bf16(cosf(ang), sinf(ang));
    }
    float* ABAR = (float*)(C.S5T + S5_ABAR); bf16_t* BFR = (bf16_t*)(C.S5T + S5_BFRAG); bf16_t* CFR = (bf16_t*)(C.S5T + S5_CFRAG);
    if (C.tid < 32) {
        const size_t e = (size_t)C.tid * 256 + (size_t)(C.bid & 255);
        const int gi = (int)(e >> 6), n = (int)(e & 63);
        const double dt = exp((double)C.in[12][gi]), ar = (double)C.in[10][e], ai = (double)C.in[11][e];
        const double mag = exp(dt * ar), abr = mag * cos(dt * ai), abi = mag * sin(dt * ai), den = ar * ar + ai * ai, xr = abr - 1.0;
        const double fre = (xr * ar + abi * ai) / den, fim = (abi * ar - xr * ai) / den;
        ABAR[2 * e] = (float)abr; ABAR[2 * e + 1] = (float)abi;
        const float* br = C.in[13] + e * 16; const float* bi = C.in[14] + e * 16;
        const int r = n & 31;
#pragma unroll
        for (int comp = 0; comp < 2; ++comp) { const int c = (n >> 5) + 2 * comp;
#pragma unroll
            for (int hh = 0; hh < 2; ++hh) { float v[8];
#pragma unroll
                for (int j = 0; j < 8; ++j) { const int p = 8 * hh + j; const double b_r = br[p], b_i = bi[p]; v[j] = (float)(comp ? (fre * b_i + fim * b_r) : (fre * b_r - fim * b_i)); }
                u32x4 w; w.x = cvt_pk_bf16(v[0], v[1]); w.y = cvt_pk_bf16(v[2], v[3]); w.z = cvt_pk_bf16(v[4], v[5]); w.w = cvt_pk_bf16(v[6], v[7]);
                *(u32x4*)(BFR + (((size_t)gi * 4 + c) * 64 + r + 32 * hh) * 8) = w; } }
    }
    for (size_t e = gtid; e < (size_t)128 * 5 * 64; e += gth) {
        const int l = (int)(e & 63), ks = (int)((e >> 6) % 5), gi = (int)(e / 320); const int p = l & 15, gq = l >> 4; float v[8];
#pragma unroll
        for (int j = 0; j < 8; ++j) { const int k = 32 * ks + 8 * gq + j;
            if (k < 128) { const int n = ((k >> 1) & 31) + 32 * (k >> 6), comp = k & 1; const size_t ci = ((size_t)gi * 16 + p) * 64 + n; v[j] = comp ? -C.in[16][ci] : C.in[15][ci]; }
            else v[j] = (k - 128 == p) ? C.in[17][gi * 16 + p] : 0.f; }
        u32x4 w; w.x = cvt_pk_bf16(v[0], v[1]); w.y = cvt_pk_bf16(v[2], v[3]); w.z = cvt_pk_bf16(v[4], v[5]); w.w = cvt_pk_bf16(v[6], v[7]);
        *(u32x4*)(CFR + e * 8) = w;
    }
}

template <int O0, int O1, int O2, int O3>
__device__ __forceinline__ void tr_frag2(unsigned addr, bf16x8& f0, bf16x8& f1) {
    u32x2 a, b, c, d;
    asm volatile("ds_read_b64_tr_b16 %0, %4 offset:%5\n\tds_read_b64_tr_b16 %1, %4 offset:%6\n\tds_read_b64_tr_b16 %2, %4 offset:%7\n\tds_read_b64_tr_b16 %3, %4 offset:%8\n\ts_waitcnt lgkmcnt(0)"
                 : "=&v"(a), "=&v"(b), "=&v"(c), "=&v"(d) : "v"(addr), "i"(O0), "i"(O1), "i"(O2), "i"(O3) : "memory");
    u32x4 x; x.x = a.x; x.y = a.y; x.z = b.x; x.w = b.y; f0 = __builtin_bit_cast(bf16x8, x);
    u32x4 y; y.x = c.x; y.y = c.y; y.z = d.x; y.w = d.y; f1 = __builtin_bit_cast(bf16x8, y);
}
__device__ __forceinline__ void ret_prompt_unit(const Ctx& C, LAS unsigned char* lds, int b, int h) {
    const int tid = C.tid, lane = C.lane, w = C.wave, fr = lane & 15, gq = lane >> 4;
    constexpr int QP = 272, VP = 528, PP = 144;
    LAS unsigned char* Qs = lds; LAS unsigned char* Ks = lds + 17408; LAS unsigned char* Vs = lds + 34816; LAS unsigned char* Ps = lds + 68608;
    LAS float* RED = (LAS float*)(lds + 77824);
    const bf16_t* Z = C.Z;
    f32x4 S[8][2];
#pragma unroll
    for (int i = 0; i < 8; ++i) { S[i][0] = (f32x4){0.f, 0.f, 0.f, 0.f}; S[i][1] = (f32x4){0.f, 0.f, 0.f, 0.f}; }
    const float g64 = exp2f(C.lg2g[h] * 64.f);
    const int qrow = tid >> 4, qc = tid & 15, vrow = tid >> 5, vc = tid & 31;
    const bf16_t* zq = Z + ((size_t)b * 2048 + qrow) * ZLD + ZQ + h * 128 + 8 * qc;
    const bf16_t* zv = Z + ((size_t)b * 2048 + vrow) * ZLD + ZV + h * 256 + 8 * vc;
    u32x4 rq[2], rk[2], rv[4]; u32x2 rg[4];
    const unsigned char* zg = gate8(Z, (size_t)b * 2048 + vrow, ZGR, h * 256 + 8 * vc);
#pragma unroll
    for (int s = 0; s < 2; ++s) { rq[s] = *(const u32x4*)(zq + (size_t)(32 * s) * ZLD); rk[s] = *(const u32x4*)(zq + (size_t)(32 * s) * ZLD + (ZK - ZQ)); }
#pragma unroll
    for (int s = 0; s < 4; ++s) { rv[s] = *(const u32x4*)(zv + (size_t)(16 * s) * ZLD); rg[s] = *(const u32x2*)(zg + (size_t)(16 * s) * (ZLD * 2)); }
    const unsigned trv = (unsigned)(size_t)(Vs + VP * (8 * gq + (fr >> 2)) + 8 * (fr & 3) + 64 * w);
    const unsigned trk = (unsigned)(size_t)(Ks + QP * (8 * gq + (fr >> 2)) + 8 * (fr & 3));
    u32x2 wvp[4];
#pragma unroll 1
    for (int c = 0; c < 32; ++c) {
        const size_t t0 = (size_t)b * 2048 + 64 * c;
        __syncthreads();
#pragma unroll
        for (int s = 0; s < 2; ++s) { *(LAS u32x4*)(Qs + (qrow + 32 * s) * QP + 16 * qc) = rq[s]; *(LAS u32x4*)(Ks + (qrow + 32 * s) * QP + 16 * qc) = rk[s]; }
#pragma unroll
        for (int s = 0; s < 4; ++s) *(LAS u32x4*)(Vs + (vrow + 16 * s) * VP + 16 * vc) = rv[s];
        u32x2 gcur[4];
#pragma unroll
        for (int s = 0; s < 4; ++s) gcur[s] = rg[s];
        if (tid < 128) RED[tid] = 0.f;
        if (c > 0) {
#pragma unroll
            for (int s = 0; s < 4; ++s) *(u32x2*)(C.A8 + (t0 - 64 + vrow + 16 * s) * LDA8 + AC_RET + h * 256 + 8 * vc) = wvp[s]; }
        if (c < 31) {
            const size_t adv = (size_t)(64 * (c + 1)) * ZLD;
#pragma unroll
            for (int s = 0; s < 2; ++s) { rq[s] = *(const u32x4*)(zq + adv + (size_t)(32 * s) * ZLD); rk[s] = *(const u32x4*)(zq + adv + (size_t)(32 * s) * ZLD + (ZK - ZQ)); }
#pragma unroll
            for (int s = 0; s < 4; ++s) { rv[s] = *(const u32x4*)(zv + adv + (size_t)(16 * s) * ZLD); rg[s] = *(const u32x2*)(zg + (adv + (size_t)(16 * s) * ZLD) * 2); }
        }
        __syncthreads();
        { const int ti = w >> 1;
#pragma unroll
          for (int q2 = 0; q2 < 2; ++q2) { const int tj = 2 * (w & 1) + q2; f32x4 pa = (f32x4){0.f, 0.f, 0.f, 0.f};
            if (tj <= ti) {
#pragma unroll
                for (int ks = 0; ks < 4; ++ks) { const bf16x8 a = *(const LAS bf16x8*)(Qs + (16 * ti + fr) * QP + (32 * ks + 8 * gq) * 2); const bf16x8 bb = *(const LAS bf16x8*)(Ks + (16 * tj + fr) * QP + (32 * ks + 8 * gq) * 2); pa = mfma16(a, bb, pa); } }
#pragma unroll
            for (int r = 0; r < 4; ++r) { const int i = 16 * ti + 4 * gq + r, j = 16 * tj + fr; const float v = (tj <= ti && i >= j) ? pa[r] : 0.f; *(LAS unsigned short*)(Ps + i * PP + 2 * j) = f2bf(v); } } }
        __builtin_amdgcn_sched_barrier(0);
        f32x4 o[4][2];
#pragma unroll
        for (int mt = 0; mt < 4; ++mt) { o[mt][0] = (f32x4){0.f, 0.f, 0.f, 0.f}; o[mt][1] = (f32x4){0.f, 0.f, 0.f, 0.f}; }
#pragma unroll
        for (int ks = 0; ks < 4; ++ks) {
            bf16x8 bfr[2];
#pragma unroll
            for (int nt = 0; nt < 2; ++nt) { u32x4 wv; wv.x = cvt_pk_bf16(S[2 * ks][nt][0], S[2 * ks][nt][1]); wv.y = cvt_pk_bf16(S[2 * ks][nt][2], S[2 * ks][nt][3]);
                wv.z = cvt_pk_bf16(S[2 * ks + 1][nt][0], S[2 * ks + 1][nt][1]); wv.w = cvt_pk_bf16(S[2 * ks + 1][nt][2], S[2 * ks + 1][nt][3]); bfr[nt] = __builtin_bit_cast(bf16x8, wv); }
#pragma unroll
            for (int mt = 0; mt < 4; ++mt) { const u32x2 lo = *(const LAS u32x2*)(Qs + (16 * mt + fr) * QP + (32 * ks + 4 * gq) * 2), hi = *(const LAS u32x2*)(Qs + (16 * mt + fr) * QP + (32 * ks + 16 + 4 * gq) * 2);
                u32x4 av; av.x = lo.x; av.y = lo.y; av.z = hi.x; av.w = hi.y; const bf16x8 a = __builtin_bit_cast(bf16x8, av);
                o[mt][0] = mfma16(a, bfr[0], o[mt][0]); o[mt][1] = mfma16(a, bfr[1], o[mt][1]); }
            __builtin_amdgcn_sched_barrier(0);
        }
        __syncthreads();
        bf16x8 vfr[2][2];
        tr_frag2<0, 4 * VP, 32 * VP, 36 * VP>(trv, vfr[0][0], vfr[0][1]);
        tr_frag2<32, 32 + 4 * VP, 32 + 32 * VP, 32 + 36 * VP>(trv, vfr[1][0], vfr[1][1]);
#pragma unroll
        for (int mt = 0; mt < 4; ++mt)
#pragma unroll
            for (int ks = 0; ks < 2; ++ks) if (ks == 0 || mt >= 2) { const bf16x8 a = *(const LAS bf16x8*)(Ps + (16 * mt + fr) * PP + (32 * ks + 8 * gq) * 2);
                o[mt][0] = mfma16(a, vfr[0][ks], o[mt][0]); o[mt][1] = mfma16(a, vfr[1][ks], o[mt][1]); }
#define RP_SUPD(md) do { bf16x8 ka0, ka1; tr_frag2<32 * (md), 32 * (md) + 4 * QP, 32 * (md) + 32 * QP, 32 * (md) + 36 * QP>(trk, ka0, ka1); \
            S[md][0] = mfma16(ka0, vfr[0][0], S[md][0]); S[md][1] = mfma16(ka0, vfr[1][0], S[md][1]); S[md][0] = mfma16(ka1, vfr[0][1], S[md][0]); S[md][1] = mfma16(ka1, vfr[1][1], S[md][1]); \
            S[md][0] = S[md][0] * g64; S[md][1] = S[md][1] * g64; } while (0)
        RP_SUPD(0); RP_SUPD(1); RP_SUPD(2); RP_SUPD(3); RP_SUPD(4); RP_SUPD(5); RP_SUPD(6); RP_SUPD(7);
#undef RP_SUPD
#pragma unroll
        for (int mt = 0; mt < 4; ++mt) { float s1v[4], s2v[4];
#pragma unroll
            for (int r = 0; r < 4; ++r) { s1v[r] = row16_sum(o[mt][0][r] + o[mt][1][r]); s2v[r] = row16_sum(o[mt][0][r] * o[mt][0][r] + o[mt][1][r] * o[mt][1][r]); }
            if (fr == 0) {
#pragma unroll
                for (int r = 0; r < 4; ++r) { const int i = 16 * mt + 4 * gq + r; __hip_atomic_fetch_add(RED + 2 * i, s1v[r], __ATOMIC_RELAXED, __HIP_MEMORY_SCOPE_WORKGROUP); __hip_atomic_fetch_add(RED + 2 * i + 1, s2v[r], __ATOMIC_RELAXED, __HIP_MEMORY_SCOPE_WORKGROUP); } } }
        __syncthreads();
        LAS unsigned char* obw = opq(Qs + (4 * gq) * 528 + (32 * w + fr) * 2);
#pragma unroll
        for (int mt = 0; mt < 4; ++mt)
#pragma unroll
            for (int r = 0; r < 4; ++r) { const int i = 16 * mt + 4 * gq + r; const float mean = RED[2 * i] * (1.f / 256.f); const float var = fmaxf(RED[2 * i + 1] * (1.f / 256.f) - mean * mean, 0.f); const float rstd = rsqrtf(var + 1e-5f);
#pragma unroll
                for (int nt = 0; nt < 2; ++nt) *(LAS unsigned short*)(obw + (16 * mt + r) * 528 + 32 * nt) = f2bf((o[mt][nt][r] - mean) * rstd); }
        __syncthreads();
#pragma unroll
        for (int s = 0; s < 4; ++s) { const int row = vrow + 16 * s;
            const u32x4 ov = *(const LAS u32x4*)(Qs + row * 528 + 16 * vc);
            float gv[8]; unpack8_fp8(gcur[s], gv);
            float pv[8];
#pragma unroll
            for (int q = 0; q < 4; ++q) { pv[2 * q] = __uint_as_float(ov[q] << 16) * gv[2 * q] * (ACS / GSC); pv[2 * q + 1] = __uint_as_float(ov[q] & 0xffff0000u) * gv[2 * q + 1] * (ACS / GSC); }
            wvp[s].x = pk4_fp8(pv[0], pv[1], pv[2], pv[3]); wvp[s].y = pk4_fp8(pv[4], pv[5], pv[6], pv[7]); }
    }
#pragma unroll
    for (int s = 0; s < 4; ++s) *(u32x2*)(C.A8 + ((size_t)b * 2048 + 64 * 31 + vrow + 16 * s) * LDA8 + AC_RET + h * 256 + 8 * vc) = wvp[s];
    GAS float* so = opqg(C.out + O_RETP + ((size_t)(b * 16 + h) * 128 + 4 * gq) * 256 + 32 * w + fr);
#pragma unroll
    for (int md = 0; md < 8; ++md) { GAS float* sp = opqg((float*)(so + (size_t)(16 * md) * 256));
#pragma unroll
        for (int nt = 0; nt < 2; ++nt)
#pragma unroll
            for (int r = 0; r < 4; ++r) sp[r * 256 + 16 * nt] = S[md][nt][r]; }
}

__device__ __forceinline__ void rs_request(const Ctx& C, int id, unsigned short (&qkv)[8], unsigned& gw, f32x4 (&st)[16]) {
    const int tid = C.tid, lane = C.lane, w = C.wave, b = id >> 4, h = id & 15, e4 = 4 * lane;
    const bf16_t* Z = C.Z; const size_t t0 = (size_t)TP + (size_t)b * 8;
    const bf16_t* zr = Z + t0 * ZLD + ((tid < 128) ? (ZQ + h * 128 + tid) : (tid < 256) ? (ZK + h * 128 + tid - 128) : (ZV + h * 256 + tid - 256));
#pragma unroll
    for (int i = 0; i < 8; ++i) qkv[i] = zr[(size_t)i * ZLD];
    gw = *(const unsigned*)gate8(Z, t0 + w, ZGR, h * 256 + e4);
    const float* sin_ = C.in[3] + ((size_t)(b * 16 + h) * 128 + 16 * w) * 256 + e4;
#pragma unroll
    for (int dd = 0; dd < 16; ++dd) st[dd] = *(const f32x4*)(sin_ + (size_t)dd * 256);
}
__device__ __forceinline__ void ret_sample_stream(const Ctx& C, LAS unsigned char* lds, unsigned* queue, volatile LAS unsigned* slot, int nunits) {
    const int tid = C.tid, lane = C.lane, w = C.wave, e4 = 4 * lane;
    LAS float* qT = (LAS float*)lds;
    LAS float* kT = (LAS float*)(lds + 4096);
    LAS float* vS = (LAS float*)(lds + 8192);
    LAS float* pS = (LAS float*)(lds + 16384);
    LAS float* red = (LAS float*)(lds + 16640);
    int id;
    __syncthreads();
    if (tid == 0) *slot = __hip_atomic_fetch_add(queue, 1u, __ATOMIC_RELAXED, __HIP_MEMORY_SCOPE_AGENT);
    __syncthreads();
    id = (int)__builtin_amdgcn_readfirstlane(*slot);
    if (id >= nunits) return;
    unsigned short qkv[8]; unsigned gw; f32x4 st[16];
    rs_request(C, id % 2048, qkv, gw, st);
#pragma unroll 1
    for (;;) {
        const int uid = id % 2048, b = uid >> 4, h = uid & 15; const size_t t0 = (size_t)TP + (size_t)b * 8;
        unsigned nid_r = 0u;
        if (tid == 0) nid_r = __hip_atomic_fetch_add(queue, 1u, __ATOMIC_RELAXED, __HIP_MEMORY_SCOPE_AGENT);
        __syncthreads();
        if (tid < 256) { LAS float* dst = (tid < 128) ? (qT + tid * 8) : (kT + (tid - 128) * 8);
#pragma unroll
            for (int i = 0; i < 8; ++i) dst[i] = bf2f(qkv[i]);
        } else { const int e = tid - 256;
#pragma unroll
            for (int i = 0; i < 8; ++i) vS[i * 256 + e] = bf2f(qkv[i]);
        }
        __syncthreads();
        { const int pr = tid >> 3, i = pr >> 3, j = pr & 7, d0 = 16 * (tid & 7); float sacc = 0.f;
#pragma unroll
          for (int d = 0; d < 16; ++d) sacc += qT[(d0 + d) * 8 + i] * kT[(d0 + d) * 8 + j];
          sacc += dpp_mov<0xB1>(sacc); sacc += dpp_mov<0x4E>(sacc); sacc += dpp_mov<0x141>(sacc);
          if ((tid & 7) == 0) pS[pr] = (j <= i) ? sacc : 0.f; }
        const float g8 = exp2f(C.lg2g[h] * 8.f);
        f32x4 v4[8], o[8];
#pragma unroll
        for (int j = 0; j < 8; ++j) { v4[j] = *(const LAS f32x4*)(vS + j * 256 + e4); o[j] = (f32x4){0.f, 0.f, 0.f, 0.f}; }
        float* sout = C.out + O_RETS + ((size_t)(b * 16 + h) * 128 + 16 * w) * 256 + e4;
#pragma unroll
        for (int dd = 0; dd < 16; ++dd) { const int d = 16 * w + dd;
            const f32x4 q0 = *(const LAS f32x4*)(qT + d * 8), q1 = *(const LAS f32x4*)(qT + d * 8 + 4), k0 = *(const LAS f32x4*)(kT + d * 8), k1 = *(const LAS f32x4*)(kT + d * 8 + 4);
            const f32x4 sv = st[dd]; f32x4 sn = sv;
#pragma unroll
            for (int i = 0; i < 4; ++i) { o[i] += sv * q0[i]; o[4 + i] += sv * q1[i]; sn += v4[i] * k0[i]; sn += v4[4 + i] * k1[i]; }
            *(f32x4*)(sout + (size_t)dd * 256) = sn * g8; }
#pragma unroll
        for (int i = 0; i < 8; ++i) *(LAS f32x4*)(red + (w * 8 + i) * 256 + e4) = o[i];
        if (tid == 0) *slot = nid_r;
        __syncthreads();
        const int nid = (int)__builtin_amdgcn_readfirstlane(*slot);
        const unsigned gcur = gw;
        if (nid < nunits) rs_request(C, nid % 2048, qkv, gw, st);
        { const int i = w; f32x4 a = (f32x4){0.f, 0.f, 0.f, 0.f};
#pragma unroll
          for (int ww = 0; ww < 8; ++ww) a += *(const LAS f32x4*)(red + (ww * 8 + i) * 256 + e4);
#pragma unroll
          for (int j = 0; j < 8; ++j) a += *(const LAS f32x4*)(vS + j * 256 + e4) * pS[i * 8 + j];
          const float mean = wave_sum((a[0] + a[1]) + (a[2] + a[3])) * (1.f / 256.f);
          const f32x4 dv = a - mean; const float var = wave_sum((dv[0] * dv[0] + dv[1] * dv[1]) + (dv[2] * dv[2] + dv[3] * dv[3])) * (1.f / 256.f);
          const float rstd = rsqrtf(var + 1e-5f);
          float g4[4]; unpack4_fp8(gcur, g4); const float g0 = g4[0], g1 = g4[1], g2 = g4[2], g3 = g4[3];
          const float rs8 = rstd * (ACS / GSC);
          *(unsigned*)(C.A8 + (t0 + i) * LDA8 + AC_RET + h * 256 + e4) = pk4_fp8(dv[0] * rs8 * g0, dv[1] * rs8 * g1, dv[2] * rs8 * g2, dv[3] * rs8 * g3); }
        if (nid >= nunits) break;
        id = nid;
    }
}

struct S5Tab { bf16x8 bf[4]; bf16x8 cf[5]; float ar0, ai0, ar1, ai1; };
constexpr int S5_WB = 12288, YWP = 48;
constexpr int HTP = 336;
__device__ __forceinline__ void s5_load_tab(const Ctx& C, int gi, int lane, S5Tab& T) {
    const bf16_t* BFR = (const bf16_t*)(C.S5T + S5_BFRAG); const bf16_t* CFR = (const bf16_t*)(C.S5T + S5_CFRAG); const float* ABAR = (const float*)(C.S5T + S5_ABAR);
#pragma unroll
    for (int c = 0; c < 4; ++c) T.bf[c] = *(const bf16x8*)(BFR + (((size_t)gi * 4 + c) * 64 + lane) * 8);
#pragma unroll
    for (int c = 0; c < 5; ++c) T.cf[c] = *(const bf16x8*)(CFR + (((size_t)gi * 5 + c) * 64 + lane) * 8);
    const int r = lane & 31; T.ar0 = ABAR[((size_t)gi * 64 + r) * 2]; T.ai0 = ABAR[((size_t)gi * 64 + r) * 2 + 1]; T.ar1 = ABAR[((size_t)gi * 64 + 32 + r) * 2]; T.ai1 = ABAR[((size_t)gi * 64 + 32 + r) * 2 + 1];
}
#define S5_BU(afrag) \
    f32x16 bre0 = __builtin_amdgcn_mfma_f32_32x32x16_bf16(afrag, T.bf[0], zero16, 0, 0, 0), bre1 = __builtin_amdgcn_mfma_f32_32x32x16_bf16(afrag, T.bf[1], zero16, 0, 0, 0), \
           bim0 = __builtin_amdgcn_mfma_f32_32x32x16_bf16(afrag, T.bf[2], zero16, 0, 0, 0), bim1 = __builtin_amdgcn_mfma_f32_32x32x16_bf16(afrag, T.bf[3], zero16, 0, 0, 0); \
      \
    __builtin_amdgcn_sched_barrier(0); asm volatile("s_nop 15\n\ts_nop 15" : "+v"(bre0), "+v"(bre1), "+v"(bim0), "+v"(bim1)); __builtin_amdgcn_sched_barrier(0)
#define S5_STEP(t) do { const float nr0 = __builtin_fmaf(T.ar0, hr0, __builtin_fmaf(-T.ai0, hi0, bre0[t])), ni0 = __builtin_fmaf(T.ar0, hi0, __builtin_fmaf(T.ai0, hr0, bim0[t])); hr0 = nr0; hi0 = ni0; \
                        const float nr1 = __builtin_fmaf(T.ar1, hr1, __builtin_fmaf(-T.ai1, hi1, bre1[t])), ni1 = __builtin_fmaf(T.ar1, hi1, __builtin_fmaf(T.ai1, hr1, bim1[t])); hr1 = nr1; hi1 = ni1; } while (0)
#define S5_PUT(t) do { *(LAS unsigned*)(Ht + (16 * H + (t)) * HTP + 4 * r) = cvt_pk_bf16(hr0, hi0); *(LAS unsigned*)(Ht + (16 * H + (t)) * HTP + 128 + 4 * r) = cvt_pk_bf16(hr1, hi1); } while (0)
__device__ __forceinline__ void s5_y(const S5Tab& T, const LAS unsigned char* Ht, int lane, f32x4 (&yv)[2]) {
    const int fr = lane & 15, gq = lane >> 4;
#pragma unroll
    for (int mt = 0; mt < 2; ++mt) { yv[mt] = (f32x4){0.f, 0.f, 0.f, 0.f};
#pragma unroll
        for (int ks = 0; ks < 5; ++ks) { const bf16x8 a = *(const LAS bf16x8*)(Ht + (16 * mt + fr) * HTP + (32 * ks + 8 * gq) * 2); yv[mt] = mfma16(a, T.cf[ks], yv[mt]); } }
}
__device__ __forceinline__ void s5_prompt_unit(const Ctx& C, LAS unsigned char* lds, int b, int gi) {
    const int lane = C.lane, w = C.wave, r = lane & 31, H = lane >> 5, fr = lane & 15, gq = lane >> 4;
    LAS unsigned char* Ht = lds + w * S5_WB; LAS unsigned char* Yw = Ht + 32 * HTP; LAS float* Es = (LAS float*)(lds + 8 * S5_WB);
    const bf16_t* Z = C.Z;
    S5Tab T; s5_load_tab(C, gi, lane, T);
    const f32x16 zero16 = {0.f, 0.f, 0.f, 0.f, 0.f, 0.f, 0.f, 0.f, 0.f, 0.f, 0.f, 0.f, 0.f, 0.f, 0.f, 0.f};
    const size_t tb = (size_t)b * 2048 + 256 * w;
    const int Hc = (r >> 2) & 1, reg = (r & 3) + 4 * (r >> 3);
    const bf16_t* up = Z + (tb + 128 * Hc + reg) * ZLD + ZU + gi * 16 + 8 * H;
    LAS unsigned char* uw = Ht + (16 * Hc + reg) * HTP + 256 + 16 * H;
    __syncthreads();
    if (lane < 32) *(LAS u32x4*)(Ht + lane * HTP + 288) = (u32x4){0u, 0u, 0u, 0u};
    if (lane < 32) *(LAS u32x4*)(Ht + lane * HTP + 304) = (u32x4){0u, 0u, 0u, 0u};
    float hr0 = 0.f, hi0 = 0.f, hr1 = 0.f, hi1 = 0.f;
    bf16x8 af[8];
#pragma unroll
    for (int s = 0; s < 8; ++s) af[s] = *(const bf16x8*)(up + (size_t)(16 * s) * ZLD);
#pragma unroll
    for (int s = 0; s < 8; ++s) { S5_BU(af[s]);
#pragma unroll
        for (int t = 0; t < 16; ++t) S5_STEP(t); }
    { const int sc = 2 * w + H; Es[(sc * 4 + 0) * 32 + r] = hr0; Es[(sc * 4 + 1) * 32 + r] = hi0; Es[(sc * 4 + 2) * 32 + r] = hr1; Es[(sc * 4 + 3) * 32 + r] = hi1; }
    __syncthreads();
    {
        float pr0 = T.ar0, pi0 = T.ai0, pr1 = T.ar1, pi1 = T.ai1;
#pragma unroll
        for (int q = 0; q < 7; ++q) { const float a = pr0 * pr0 - pi0 * pi0, bq = 2.f * pr0 * pi0; pr0 = a; pi0 = bq; const float c = pr1 * pr1 - pi1 * pi1, d = 2.f * pr1 * pi1; pr1 = c; pi1 = d; }
        const int sc = 2 * w + H; hr0 = 0.f; hi0 = 0.f; hr1 = 0.f; hi1 = 0.f;
#pragma unroll 1
        for (int s2 = 0; s2 < 15; ++s2) { if (s2 < sc) { const float e0 = Es[(s2 * 4 + 0) * 32 + r], e1 = Es[(s2 * 4 + 1) * 32 + r], e2 = Es[(s2 * 4 + 2) * 32 + r], e3 = Es[(s2 * 4 + 3) * 32 + r];
                const float nr0 = pr0 * hr0 - pi0 * hi0 + e0, ni0 = pr0 * hi0 + pi0 * hr0 + e1; hr0 = nr0; hi0 = ni0;
                const float nr1 = pr1 * hr1 - pi1 * hi1 + e2, ni1 = pr1 * hi1 + pi1 * hr1 + e3; hr1 = nr1; hi1 = ni1; } }
    }
    {
      unsigned char* glp = (unsigned char*)C.GL + (tb + 128 * (lane >> 5) + ((lane >> 1) & 15)) * LDG8 + gi * 16 + 8 * (lane & 1);
#pragma unroll
      for (int s = 0; s < 8; ++s) {
        S5_BU(af[s]);
        *(LAS bf16x8*)uw = af[s];
#pragma unroll
        for (int t = 0; t < 16; ++t) { S5_STEP(t); S5_PUT(t); }
        asm volatile("s_waitcnt lgkmcnt(0)" ::: "memory");
        f32x4 yv[2]; s5_y(T, Ht, lane, yv);
#pragma unroll
        for (int mt = 0; mt < 2; ++mt)
#pragma unroll
            for (int q = 0; q < 4; ++q) *(LAS unsigned short*)(Yw + (16 * mt + 4 * gq + q) * YWP + 2 * fr) = f2bf(gelu_tanh_f(yv[mt][q]));
        asm volatile("s_waitcnt lgkmcnt(0)" ::: "memory");
        *(u32x2*)(glp + (size_t)(16 * s) * LDG8) = bf8_to_fp8(*(const LAS u32x4*)(Yw + (lane >> 1) * YWP + 16 * (lane & 1)), ACS);
        asm volatile("s_waitcnt lgkmcnt(0)" ::: "memory"); } }
    if (w == 7 && H == 1) { const size_t o = ((size_t)b * 128 + gi) * 64; C.out[O_S5RP + o + r] = hr0; C.out[O_S5IP + o + r] = hi0; C.out[O_S5RP + o + 32 + r] = hr1; C.out[O_S5IP + o + 32 + r] = hi1; }
}
__device__ __forceinline__ void s5_sample_unit(const Ctx& C, LAS unsigned char* lds, int gi, int bq) {
    const int lane = C.lane, w = C.wave, r = lane & 31, H = lane >> 5, fr = lane & 15, gq = lane >> 4;
    LAS unsigned char* Ht = lds + w * S5_WB; LAS unsigned char* Yw = Ht + 32 * HTP;
    const bf16_t* Z = C.Z;
    S5Tab T; s5_load_tab(C, gi, lane, T);
    const f32x16 zero16 = {0.f, 0.f, 0.f, 0.f, 0.f, 0.f, 0.f, 0.f, 0.f, 0.f, 0.f, 0.f, 0.f, 0.f, 0.f, 0.f};
    const int bbase = 32 * bq + 4 * w;
    const int Hc = (r >> 2) & 1, reg = (r & 3) + 4 * (r >> 3);
    const bf16x8 af = *(const bf16x8*)(Z + ((size_t)TP + (size_t)(bbase + 2 * Hc + (reg >> 3)) * 8 + (reg & 7)) * ZLD + ZU + gi * 16 + 8 * H);
    const float* sre = C.in[4]; const float* sim = C.in[5];
    float h0v[2][4];
#pragma unroll
    for (int q = 0; q < 2; ++q) { const size_t so = ((size_t)(bbase + 2 * H + q) * 128 + gi) * 64; h0v[q][0] = sre[so + r]; h0v[q][1] = sim[so + r]; h0v[q][2] = sre[so + 32 + r]; h0v[q][3] = sim[so + 32 + r]; }
    __syncthreads();
    if (lane < 32) *(LAS u32x4*)(Ht + lane * HTP + 288) = (u32x4){0u, 0u, 0u, 0u};
    if (lane < 32) *(LAS u32x4*)(Ht + lane * HTP + 304) = (u32x4){0u, 0u, 0u, 0u};
    *(LAS bf16x8*)(Ht + (16 * Hc + reg) * HTP + 256 + 16 * H) = af;
    S5_BU(af);
#pragma unroll
    for (int q = 0; q < 2; ++q) { const size_t so = ((size_t)(bbase + 2 * H + q) * 128 + gi) * 64;
        float hr0 = h0v[q][0], hi0 = h0v[q][1], hr1 = h0v[q][2], hi1 = h0v[q][3];
#pragma unroll
        for (int t = 8 * q; t < 8 * q + 8; ++t) { S5_STEP(t); S5_PUT(t); }
        C.out[O_S5RS + so + r] = hr0; C.out[O_S5IS + so + r] = hi0; C.out[O_S5RS + so + 32 + r] = hr1; C.out[O_S5IS + so + 32 + r] = hi1; }
    asm volatile("s_waitcnt lgkmcnt(0)" ::: "memory");
    f32x4 yv[2]; s5_y(T, Ht, lane, yv);
#pragma unroll
    for (int mt = 0; mt < 2; ++mt)
#pragma unroll
        for (int q = 0; q < 4; ++q) *(LAS unsigned short*)(Yw + (16 * mt + 4 * gq + q) * YWP + 2 * fr) = f2bf(gelu_tanh_f(yv[mt][q]));
    asm volatile("s_waitcnt lgkmcnt(0)" ::: "memory");
    { const int row = lane >> 1, t = row & 15; const size_t tok = (size_t)TP + (size_t)(bbase + 2 * (row >> 4) + (t >> 3)) * 8 + (t & 7);
      *(u32x2*)((unsigned char*)C.GL + tok * LDG8 + gi * 16 + 8 * (lane & 1)) = bf8_to_fp8(*(const LAS u32x4*)(Yw + row * YWP + 16 * (lane & 1)), ACS); }
}

__device__ __forceinline__ void xattn_prompt_unit(const Ctx& C, LAS unsigned char* lds, int b, int hx, int qb) {
    const int tid = C.tid, lane = C.lane, w = C.wave, fr = lane & 15, gq = lane >> 4;
    LAS unsigned char* Ks = lds; LAS unsigned char* Pw = lds + 69632 + w * 8448;
    const bf16_t* Z = C.Z; const bf16_t* KVB = C.KVB;
    const size_t rowbase = (size_t)b * 2048 + 128 * qb + 16 * w;
    f32x4 S[16];
#pragma unroll
    for (int i = 0; i < 16; ++i) S[i] = (f32x4){0.f, 0.f, 0.f, 0.f};
    u32x4 kpre[8]; bf16x8 a[4];
#pragma unroll
    for (int s = 0; s < 8; ++s) { const int p = tid + 512 * s; kpre[s] = *(const u32x4*)(KVB + (size_t)(b * 256 + (p >> 4)) * 4096 + hx * 512 + 8 * (p & 15)); }
#pragma unroll
    for (int ks = 0; ks < 4; ++ks) a[ks] = *(const bf16x8*)(Z + (rowbase + fr) * ZLD + ZQX + hx * 512 + 32 * ks + 8 * gq);
#pragma unroll 1
    for (int sl = 0; sl < 4; ++sl) {
        __syncthreads();
#pragma unroll
        for (int s = 0; s < 8; ++s) { const int p = tid + 512 * s; *(LAS u32x4*)(Ks + (p >> 4) * 272 + 16 * (p & 15)) = kpre[s]; }
        bf16x8 ac[4];
#pragma unroll
        for (int ks = 0; ks < 4; ++ks) ac[ks] = a[ks];
        if (sl < 3) {
#pragma unroll
            for (int s = 0; s < 8; ++s) { const int p = tid + 512 * s; kpre[s] = *(const u32x4*)(KVB + (size_t)(b * 256 + (p >> 4)) * 4096 + hx * 512 + 128 * (sl + 1) + 8 * (p & 15)); }
#pragma unroll
            for (int ks = 0; ks < 4; ++ks) a[ks] = *(const bf16x8*)(Z + (rowbase + fr) * ZLD + ZQX + hx * 512 + 128 * (sl + 1) + 32 * ks + 8 * gq); }
        __syncthreads();
#pragma unroll
        for (int nt = 0; nt < 16; ++nt)
#pragma unroll
            for (int ks = 0; ks < 4; ++ks) { const bf16x8 bb = *(const LAS bf16x8*)(Ks + (16 * nt + fr) * 272 + (32 * ks + 8 * gq) * 2); S[nt] = mfma16(ac[ks], bb, S[nt]); }
    }
#pragma unroll
    for (int r = 0; r < 4; ++r) { float mx = S[0][r];
#pragma unroll
        for (int nt = 1; nt < 16; ++nt) mx = fmaxf(mx, S[nt][r]);
        mx = row16_max(mx);
        float sum = 0.f;
#pragma unroll
        for (int nt = 0; nt < 16; ++nt) { const float e = __expf(S[nt][r] - mx); S[nt][r] = e; sum += e; }
        sum = row16_sum(sum);
        const float inv = 1.0f / sum;
#pragma unroll
        for (int nt = 0; nt < 16; ++nt) *(LAS unsigned short*)(Pw + (4 * gq + r) * 528 + (16 * nt + fr) * 2) = f2bf(S[nt][r] * inv); }
    constexpr int VSP = 144, OWP = 144;
    LAS unsigned char* Ow = lds + 36864 + w * (16 * OWP);
    const unsigned trv = (unsigned)(size_t)(Ks + VSP * (8 * gq + (fr >> 2)) + 8 * (fr & 3));
    u32x4 vpre[4];
#pragma unroll
    for (int s = 0; s < 4; ++s) { const int p = tid + 512 * s; vpre[s] = *(const u32x4*)(KVB + (size_t)(b * 256 + (p >> 3)) * 4096 + 2048 + hx * 512 + 8 * (p & 7)); }
#pragma unroll 1
    for (int es = 0; es < 8; ++es) {
        __syncthreads();
#pragma unroll
        for (int s = 0; s < 4; ++s) { const int p = tid + 512 * s; *(LAS u32x4*)(Ks + (p >> 3) * VSP + 16 * (p & 7)) = vpre[s]; }
        if (es < 7) {
#pragma unroll
            for (int s = 0; s < 4; ++s) { const int p = tid + 512 * s; vpre[s] = *(const u32x4*)(KVB + (size_t)(b * 256 + (p >> 3)) * 4096 + 2048 + hx * 512 + 64 * (es + 1) + 8 * (p & 7)); } }
        __syncthreads();
        u32x2 gpre[2];
#pragma unroll
        for (int i = 0; i < 2; ++i) { const int pc = lane + 64 * i; gpre[i] = *(const u32x2*)gate8(Z, rowbase + (pc >> 3), ZGX, hx * 512 + 64 * es + 8 * (pc & 7)); }
        f32x4 o[4];
#pragma unroll
        for (int nt = 0; nt < 4; ++nt) o[nt] = (f32x4){0.f, 0.f, 0.f, 0.f};
#define XP_PV(j) do { const bf16x8 a0 = *(const LAS bf16x8*)(Pw + fr * 528 + (64 * (j) + 8 * gq) * 2), a1 = *(const LAS bf16x8*)(Pw + fr * 528 + (64 * (j) + 32 + 8 * gq) * 2); bf16x8 b0, b1; \
            tr_frag2<VSP * 64 * (j), VSP * 64 * (j) + 4 * VSP, VSP * 64 * (j) + 32 * VSP, VSP * 64 * (j) + 36 * VSP>(trv, b0, b1); o[0] = mfma16(a0, b0, o[0]); o[0] = mfma16(a1, b1, o[0]); \
            tr_frag2<32 + VSP * 64 * (j), 32 + VSP * 64 * (j) + 4 * VSP, 32 + VSP * 64 * (j) + 32 * VSP, 32 + VSP * 64 * (j) + 36 * VSP>(trv, b0, b1); o[1] = mfma16(a0, b0, o[1]); o[1] = mfma16(a1, b1, o[1]); \
            tr_frag2<64 + VSP * 64 * (j), 64 + VSP * 64 * (j) + 4 * VSP, 64 + VSP * 64 * (j) + 32 * VSP, 64 + VSP * 64 * (j) + 36 * VSP>(trv, b0, b1); o[2] = mfma16(a0, b0, o[2]); o[2] = mfma16(a1, b1, o[2]); \
            tr_frag2<96 + VSP * 64 * (j), 96 + VSP * 64 * (j) + 4 * VSP, 96 + VSP * 64 * (j) + 32 * VSP, 96 + VSP * 64 * (j) + 36 * VSP>(trv, b0, b1); o[3] = mfma16(a0, b0, o[3]); o[3] = mfma16(a1, b1, o[3]); } while (0)
        XP_PV(0); XP_PV(1); XP_PV(2); XP_PV(3);
#undef XP_PV
#pragma unroll
        for (int nt = 0; nt < 4; ++nt)
#pragma unroll
            for (int r = 0; r < 4; ++r) *(LAS unsigned short*)(Ow + (4 * gq + r) * OWP + (16 * nt + fr) * 2) = f2bf(o[nt][r]);
        asm volatile("s_waitcnt lgkmcnt(0)" ::: "memory");
#pragma unroll
        for (int i = 0; i < 2; ++i) { const int pc = lane + 64 * i, row = pc >> 3, c8 = pc & 7;
            const u32x4 ov = *(const LAS u32x4*)(Ow + row * OWP + 16 * c8);
            float gv[8]; unpack8_fp8(gpre[i], gv);
            float pv[8];
#pragma unroll
            for (int q = 0; q < 4; ++q) { pv[2 * q] = __uint_as_float(ov[q] << 16) * gv[2 * q] * (ACS / GSC); pv[2 * q + 1] = __uint_as_float(ov[q] & 0xffff0000u) * gv[2 * q + 1] * (ACS / GSC); }
            u32x2 wv; wv.x = pk4_fp8(pv[0], pv[1], pv[2], pv[3]); wv.y = pk4_fp8(pv[4], pv[5], pv[6], pv[7]);
            *(u32x2*)(C.A8 + (rowbase + row) * LDA8 + AC_X + hx * 512 + 64 * es + 8 * c8) = wv; }
        asm volatile("s_waitcnt lgkmcnt(0)" ::: "memory");
    }
}
struct XsK { bf16x8 a[4]; f32x4 x[4][2][2]; };
__device__ __forceinline__ void xs_kload(XsK& g, const bf16_t* zq, const float* kp, int grp, int fr) {
#pragma unroll
    for (int s = 0; s < 4; ++s) { const int ks = 4 * grp + s;
        g.a[s] = (bf16x8){0, 0, 0, 0, 0, 0, 0, 0};
        if (fr < 8) g.a[s] = *(const bf16x8*)(zq + 32 * ks);
#pragma unroll
        for (int nt = 0; nt < 2; ++nt) { const float* p = kp + (size_t)nt * (16 * 2048) + 32 * ks; g.x[s][nt][0] = *(const f32x4*)p; g.x[s][nt][1] = *(const f32x4*)(p + 4); } }
}
__device__ __forceinline__ void xs_kmma(const XsK& g, f32x4 (&S2)[2]) {
#pragma unroll
    for (int s = 0; s < 4; ++s)
#pragma unroll
        for (int nt = 0; nt < 2; ++nt) { const f32x4 x0 = g.x[s][nt][0], x1 = g.x[s][nt][1];
            u32x4 wv; wv.x = cvt_pk_bf16(x0[0], x0[1]); wv.y = cvt_pk_bf16(x0[2], x0[3]); wv.z = cvt_pk_bf16(x1[0], x1[1]); wv.w = cvt_pk_bf16(x1[2], x1[3]);
            S2[nt] = mfma16(g.a[s], __builtin_bit_cast(bf16x8, wv), S2[nt]); }
}
__device__ __forceinline__ void xs_vload(f32x4 (&vv)[16], const float* vp, int k0) {
#pragma unroll
    for (int kk = 0; kk < 16; ++kk) vv[kk] = *(const f32x4*)(vp + (size_t)(k0 + kk) * 2048);
}
__device__ __forceinline__ void xs_vfma(const f32x4 (&vv)[16], f32x4 (&o)[8], const LAS float* PT, int key0) {
#pragma unroll
    for (int kk = 0; kk < 16; ++kk) { const f32x4 p0 = *(const LAS f32x4*)(PT + (key0 + kk) * 8), p1 = *(const LAS f32x4*)(PT + (key0 + kk) * 8 + 4);
#pragma unroll
        for (int i = 0; i < 4; ++i) { o[i] += vv[kk] * p0[i]; o[4 + i] += vv[kk] * p1[i]; } }
}
__device__ __forceinline__ void xattn_sample_unit(const Ctx& C, LAS unsigned char* lds, int b, int hx) {
    const int lane = C.lane, w = C.wave, fr = lane & 15, gq = lane >> 4;
    LAS float* Ssm = (LAS float*)lds;
    LAS float* PT = (LAS float*)(lds + 8192);
    LAS float* red = (LAS float*)(lds + 16384);
    const bf16_t* Z = C.Z; const float* CK = C.in[6]; const float* CV = C.in[7];
    const size_t t0 = (size_t)TP + (size_t)b * 8;
    f32x4 S2[2] = {(f32x4){0.f, 0.f, 0.f, 0.f}, (f32x4){0.f, 0.f, 0.f, 0.f}};
    const bf16_t* zq = Z + (t0 + (fr & 7)) * ZLD + ZQX + hx * 512 + 8 * gq;
    const float* kp = CK + ((size_t)(b * 256 + 32 * w + fr) * 4 + hx) * 512 + 8 * gq;
    const int kg = w >> 1, e4 = 256 * (w & 1) + 4 * lane;
    const float* vp = CV + ((size_t)(b * 256 + 64 * kg) * 4 + hx) * 512 + e4;
    unsigned gpre[2];
#pragma unroll
    for (int j = 0; j < 2; ++j) gpre[j] = *(const unsigned*)gate8(Z, t0 + w, ZGX, hx * 512 + 4 * lane + 256 * j);
    __syncthreads();
    { XsK ga, gb;
      xs_kload(ga, zq, kp, 0, fr);
      xs_kload(gb, zq, kp, 1, fr); xs_kmma(ga, S2);
      xs_kload(ga, zq, kp, 2, fr); xs_kmma(gb, S2);
      xs_kload(gb, zq, kp, 3, fr); xs_kmma(ga, S2);
      xs_kmma(gb, S2); }
    f32x4 va[16], vb[16];
    xs_vload(va, vp, 0);
    if (gq < 2) {
#pragma unroll
        for (int nt = 0; nt < 2; ++nt)
#pragma unroll
            for (int r = 0; r < 4; ++r) Ssm[(4 * gq + r) * 256 + 32 * w + 16 * nt + fr] = S2[nt][r]; }
    __syncthreads();
    { const f32x4 sv = *(const LAS f32x4*)(Ssm + w * 256 + 4 * lane);
      const float mx = wave_max(fmaxf(fmaxf(sv[0], sv[1]), fmaxf(sv[2], sv[3])));
      f32x4 e; e[0] = __expf(sv[0] - mx); e[1] = __expf(sv[1] - mx); e[2] = __expf(sv[2] - mx); e[3] = __expf(sv[3] - mx);
      const float inv = 1.0f / wave_sum((e[0] + e[1]) + (e[2] + e[3]));
#pragma unroll
      for (int j = 0; j < 4; ++j) PT[(4 * lane + j) * 8 + w] = e[j] * inv; }
    __syncthreads();
    { f32x4 o[8];
#pragma unroll
      for (int i = 0; i < 8; ++i) o[i] = (f32x4){0.f, 0.f, 0.f, 0.f};
      xs_vload(vb, vp, 16); xs_vfma(va, o, PT, 64 * kg);
      xs_vload(va, vp, 32); xs_vfma(vb, o, PT, 64 * kg + 16);
      xs_vload(vb, vp, 48); xs_vfma(va, o, PT, 64 * kg + 32);
      xs_vfma(vb, o, PT, 64 * kg + 48);
#pragma unroll
      for (int i = 0; i < 8; ++i) *(LAS f32x4*)(red + (kg * 8 + i) * 512 + e4) = o[i]; }
    __syncthreads();
#pragma unroll
    for (int j = 0; j < 2; ++j) { const int e = 4 * lane + 256 * j; f32x4 a = (f32x4){0.f, 0.f, 0.f, 0.f};
#pragma unroll
        for (int kg2 = 0; kg2 < 4; ++kg2) a += *(const LAS f32x4*)(red + (kg2 * 8 + w) * 512 + e);
        float g4[4]; unpack4_fp8(gpre[j], g4);
        *(unsigned*)(C.A8 + (t0 + w) * LDA8 + AC_X + hx * 512 + e) = pk4_fp8(a[0] * g4[0] * (ACS / GSC), a[1] * g4[1] * (ACS / GSC), a[2] * g4[2] * (ACS / GSC), a[3] * g4[3] * (ACS / GSC)); }
}

constexpr int U_RP = 64, U_XP = 256, U_SP = 512, U_SS = 512, U_XS = 512, U_RS = 2048;
constexpr int U_TOTAL = U_RP + U_XP + U_SP + U_SS + U_XS + U_RS;
__device__ __forceinline__ int q_fetch(const Ctx& C, unsigned* q, volatile LAS unsigned* slot) {
    __syncthreads();
    if (C.tid == 0) *slot = __hip_atomic_fetch_add(q, 1u, __ATOMIC_RELAXED, __HIP_MEMORY_SCOPE_AGENT);
    __syncthreads();
    return (int)__builtin_amdgcn_readfirstlane(*slot);
}
#define Q_LOOP(qptr, N, U, CALL) do { int id = q_fetch(C, (qptr), slot); \
    _Pragma("unroll 1") while (id < (N)) { unsigned nx_ = 0u; if (C.tid == 0) nx_ = __hip_atomic_fetch_add((qptr), 1u, __ATOMIC_RELAXED, __HIP_MEMORY_SCOPE_AGENT); \
        id %= (U); CALL; __syncthreads(); if (C.tid == 0) *slot = nx_; __syncthreads(); id = (int)__builtin_amdgcn_readfirstlane(*slot); } } while (0)
#ifndef P2_NSTREAM
#define P2_NSTREAM 4
#endif
__device__ __forceinline__ void p2_streams(const Ctx& C, LAS unsigned char* lds, unsigned* queue, volatile LAS unsigned* slot) {
#ifndef DIS_XS
#pragma unroll 1
    Q_LOOP(queue + 256, REP_XS * U_XS, U_XS, xattn_sample_unit(C, lds, id >> 2, id & 3));
#endif
#ifndef DIS_RS
    ret_sample_stream(C, lds, queue + 320, slot, REP_RS * U_RS);
#endif
}
__device__ __forceinline__ void p2_mixers(const Ctx& C, LAS unsigned char* lds, unsigned* queue, volatile LAS unsigned* slot) {
    if (((C.bid >> 3) & 7) < P2_NSTREAM) p2_streams(C, lds, queue, slot);
#ifndef DIS_RP
#pragma unroll 1
    for (;;) { int id = q_fetch(C, queue, slot); if (id >= REP_RP * U_RP) break; id %= U_RP; ret_prompt_unit(C, lds, id >> 4, id & 15); }
#endif
#ifndef DIS_XP
#pragma unroll 1
    Q_LOOP(queue + 64, REP_XP * U_XP, U_XP, xattn_prompt_unit(C, lds, id >> 6, (id >> 4) & 3, id & 15));
#endif
#ifndef DIS_SP
#pragma unroll 1
    Q_LOOP(queue + 128, REP_SP * U_SP, U_SP, s5_prompt_unit(C, lds, id >> 7, id & 127));
#endif
#ifndef DIS_SS
#pragma unroll 1
    Q_LOOP(queue + 192, REP_SS * U_SS, U_SS, s5_sample_unit(C, lds, id & 127, id >> 7));
#endif
    p2_streams(C, lds, queue, slot);
}

__device__ __forceinline__ void p6_layernorm(const Ctx& C) {
    const int gw = C.bid * 8 + C.wave, NGW = C.G * 8;
    const float* lg = C.in[23]; const float* lb = C.in[24];
    f32x4 gg[16], bb[16];
#pragma unroll
    for (int j = 0; j < 8; ++j) { const int c4 = 128 * j + 2 * C.lane;
        gg[2 * j] = ((const f32x4*)lg)[c4]; gg[2 * j + 1] = ((const f32x4*)lg)[c4 + 1]; bb[2 * j] = ((const f32x4*)lb)[c4]; bb[2 * j + 1] = ((const f32x4*)lb)[c4 + 1]; }
    u32x4 wn[8];
    if (gw < TT) { const u32x4* vp = (const u32x4*)(C.ACAT + (size_t)gw * ALD) + C.lane;
#pragma unroll
        for (int j = 0; j < 8; ++j) wn[j] = vp[64 * j]; }
#pragma unroll 1
    for (int row = gw; row < TT; row += NGW) {
        f32x4 v[16]; float s = 0.f;
#pragma unroll
        for (int j = 0; j < 8; ++j) { const u32x4 w = wn[j];
            v[2 * j] = (f32x4){__uint_as_float(w.x << 16), __uint_as_float(w.x & 0xffff0000u), __uint_as_float(w.y << 16), __uint_as_float(w.y & 0xffff0000u)};
            v[2 * j + 1] = (f32x4){__uint_as_float(w.z << 16), __uint_as_float(w.z & 0xffff0000u), __uint_as_float(w.w << 16), __uint_as_float(w.w & 0xffff0000u)};
            s += ((v[2 * j][0] + v[2 * j][1]) + (v[2 * j][2] + v[2 * j][3])) + ((v[2 * j + 1][0] + v[2 * j + 1][1]) + (v[2 * j + 1][2] + v[2 * j + 1][3])); }
        if (row + NGW < TT) { const u32x4* vp = (const u32x4*)(C.ACAT + (size_t)(row + NGW) * ALD) + C.lane;
#pragma unroll
            for (int j = 0; j < 8; ++j) wn[j] = vp[64 * j]; }
        const float mean = wave_sum(s) * (1.f / DM); float q = 0.f;
#pragma unroll
        for (int j = 0; j < 16; ++j) { v[j] = v[j] - mean; q += (v[j][0] * v[j][0] + v[j][1] * v[j][1]) + (v[j][2] * v[j][2] + v[j][3] * v[j][3]); }
        const float rstd = rsqrtf(wave_sum(q) * (1.f / DM) + 1e-5f);
        f32x4* op = (f32x4*)(C.out + (size_t)row * DM) + 2 * C.lane;
#pragma unroll
        for (int j = 0; j < 8; ++j) { op[128 * j] = v[2 * j] * rstd * gg[2 * j] + bb[2 * j]; op[128 * j + 1] = v[2 * j + 1] * rstd * gg[2 * j + 1] + bb[2 * j + 1]; }
    }
}

__global__ void __launch_bounds__(512, 2) mk_fwd(Args args) {
    extern __shared__ __attribute__((aligned(16))) unsigned char lds_raw[];
    LAS unsigned char* lds = (LAS unsigned char*)lds_raw;
    Ctx C;
    C.in = args.in; C.out = args.out; C.ws = args.ws; C.lg2g = args.lg2g;
    C.tid = threadIdx.x; C.lane = C.tid & 63; C.wave = __builtin_amdgcn_readfirstlane(C.tid >> 6); C.G = gridDim.x; C.bid = blockIdx.x;
    unsigned char* ws = args.ws;
    C.XB = (bf16_t*)(ws + WS_XB); C.MEMB = (bf16_t*)(ws + WS_MEMB); C.WIN = (bf16_t*)(ws + WS_WIN); C.WMKV = (bf16_t*)(ws + WS_WMKV); C.WGLU = (bf16_t*)(ws + WS_WGLU);
    C.WCAT = (bf16_t*)(ws + WS_WCAT); C.WOUT = (bf16_t*)(ws + WS_WOUT); C.Z = (bf16_t*)(ws + WS_Z); C.ACAT = (bf16_t*)(ws + WS_ACAT); C.A8 = ws + WS_ACAT; C.GL = (bf16_t*)(ws + WS_GL);
    C.MERGED = (bf16_t*)(ws + WS_MERGED); C.KVB = (bf16_t*)(ws + WS_KVB); C.ROPE = (float*)(ws + WS_ROPE); C.S5T = ws + WS_S5;
    unsigned* ctl = (unsigned*)(ws + WS_CTL);
    volatile LAS unsigned* MISC = (volatile LAS unsigned*)(lds + LDS_BYTES - 64);
    if (C.tid < 16) MISC[C.tid] = 0u;
    __syncthreads();
    const int lo = args.ph_lo, hi = args.ph_hi;
    const bool use_bar = (hi - lo) > 1;
    XcdBarrier bar; bar.bar = ctl + CW_BAR; bar.x = 0; bar.st = nullptr;
    if (use_bar) bar = xcd_barrier_post(ctl + CW_BAR, MISC + 8);
#define IN(k) (lo <= (k) && (k) < hi)
    const int su_tl = C.bid >> 2, su_kq = C.bid & 3;
    unsigned char* su_slab = ws + WS_SLAB + (size_t)su_tl * 4 * SLAB_BYTES;
#define SEAM(k) do { if (IN(k) && IN((k) + 1)) xcd_barrier(bar); } while (0)

#ifndef DIS_P0
    if (IN(0)) {
#pragma unroll 1
        for (int rep = 0; rep < REP_P0; ++rep) { if (rep) xcd_barrier(bar); p0_prologue(C, lds); } }
#endif
    SEAM(0);
    if (IN(1)) {
#ifndef DIS_P1A
        {
          pg8::Gemm g{(const bf16_t*)(ws + WS_XB8), (const bf16_t*)(ws + WS_WIN8), TT, 24576, DM / 2, LD8 / 2, LD8 / 2}; pg8::StaticOrder S; S.init(TT, 24576, C.G, C.bid); EpiZ E{C.Z, C.ROPE, C.lg2g, 2, ws + WS_ZM8};
          pg8::gemm_phase<EpiZ, pg8::StaticOrder, PG8_ALIGN, PG8_SP2, true>(lds, g, S, E); }
        {
          pg8::Gemm g{C.XB, C.WIN, TT, 8192, DM, LDX, LDX}; pg8::StaticOrder S; S.init(TT, 8192, C.G, C.G - 1 - C.bid); EpiZ E{C.Z, C.ROPE, C.lg2g, 1, ws + WS_ZM8};
          pg8::gemm_phase<EpiZ, pg8::StaticOrder, PG8_ALIGN, PG8_SP2>(lds, g, S, E); }
#endif
#ifndef DIS_P1B
        if (C.bid < 128) {
          const int mt = C.bid >> 1, mh2 = C.bid & 1;
          pg8::Gemm g{C.MEMB + mh2 * 2048, C.WMKV + mh2 * 2048, 1024, DM, 2048, LDX, LDX}; OneUnit S{Unit{mt >> 4, mt & 15}};
          EpiSplit<EpiKV, 2> E{EpiKV{C.out + O_MK, C.out + O_MV, C.KVB}, ws + WS_SLAB + (size_t)mt * 4 * SLAB_BYTES, ctl + CW_TICKET + (0 * 64 + mt) * 64, mh2};
          pg8::gemm_phase<EpiSplit<EpiKV, 2>, OneUnit, false, PG8_SP2>(lds, g, S, E); }
#endif
    } SEAM(1);
    if (IN(2)) { p2_mixers(C, lds, ctl + CW_QUEUE, MISC + 4); }
    SEAM(2);
#ifndef DIS_P3
    if (IN(3)) {
        OneUnit SU{Unit{32 + (su_tl >> 4), su_tl & 15}}; EpiSplit<EpiGlu, 4, true> ES{EpiGlu{C.Z, C.A8}, su_slab, ctl + CW_TICKET + (1 * 64 + su_tl) * 64, su_kq};
        { pg8::Gemm g{C.GL + su_kq * 256, C.WGLU + su_kq * 256, TT, DM, 256, LDG8 / 2, LDG8 / 2, 0x7c78};
          pg8::gemm_phase<EpiSplit<EpiGlu, 4, true>, OneUnit, false, PG8_SP2, true>(lds, g, SU, ES); }
        { pg8::Gemm g{C.GL, C.WGLU, TP, DM, 1024, LDG8 / 2, LDG8 / 2, 0x7c78}; pg8::StaticOrder S; S.init(TP, DM, C.G, C.bid); EpiGlu E{C.Z, C.A8};
          pg8::gemm_phase<EpiGlu, pg8::StaticOrder, PG8_ALIGN, PG8_SP2, true>(lds, g, S, E); }
        ES.finish(SU.u); }
#endif
    SEAM(3);
#ifndef DIS_P4
    if (IN(4)) {
        OneUnit SU{Unit{32 + (su_tl >> 4), su_tl & 15}}; EpiSplit<EpiProjQ, 4, true> ES{EpiProjQ{ws + WS_ZM8, (unsigned char*)C.MERGED}, su_slab, ctl + CW_TICKET + (2 * 64 + su_tl) * 64, su_kq};
        { pg8::Gemm g{C.ACAT + su_kq * 1024, C.WCAT + su_kq * 1024, TT, DM, 1024, LDA8 / 2, LDA8 / 2, 0x7c78};
          pg8::gemm_phase<EpiSplit<EpiProjQ, 4, true>, OneUnit, false, PG8_SP2, true>(lds, g, SU, ES); }
        { pg8::Gemm g{C.ACAT, C.WCAT, TP, DM, 4096, LDA8 / 2, LDA8 / 2, 0x7c78}; pg8::StaticOrder S; S.init(TP, DM, C.G, C.bid); EpiProj E{ws + WS_ZM8, (unsigned char*)C.MERGED};
          pg8::gemm_phase<EpiProj, pg8::StaticOrder, PG8_ALIGN, PG8_SP2, true>(lds, g, S, E); }
        ES.finish(SU.u); }
#endif
    SEAM(4);
#ifndef DIS_P5
    if (IN(5)) {
        OneUnit SU{Unit{32 + (su_tl >> 4), su_tl & 15}}; EpiSplit<EpiOut, 4, true> ES{EpiOut{C.XB, C.ACAT}, su_slab, ctl + CW_TICKET + (3 * 64 + su_tl) * 64, su_kq};
        { pg8::Gemm g{C.MERGED + su_kq * 512, C.WOUT + su_kq * 512, TT, DM, 512, LD8 / 2, LD8 / 2, 0x7b78};
          pg8::gemm_phase<EpiSplit<EpiOut, 4, true>, OneUnit, false, PG8_SP2, true>(lds, g, SU, ES); }
        { pg8::Gemm g{C.MERGED, C.WOUT, TP, DM, DM / 2, LD8 / 2, LD8 / 2, 0x7b78}; pg8::StaticOrder S; S.init(TP, DM, C.G, C.bid); EpiOut E{C.XB, C.ACAT};
          pg8::gemm_phase<EpiOut, pg8::StaticOrder, PG8_ALIGN, PG8_SP2, true>(lds, g, S, E); }
        ES.finish(SU.u); }
#endif
    SEAM(5);
#ifndef DIS_P6
    if (IN(6)) { p6_layernorm(C); }
#endif
#undef IN
#undef SEAM
}

extern "C" void kernel_launch(void* const* d_in, const int* in_sizes, int n_in, void* d_out, int out_size, void* d_ws, size_t ws_size, hipStream_t stream) {
    static int grid = 0;
    if (grid == 0) {
        if (n_in != 25 || (size_t)out_size != O_END || ws_size < WS_END) { fprintf(stderr, "kernel_launch: unexpected shapes (n_in %d, out %d, ws %zu)\n", n_in, out_size, ws_size); grid = -1; return; }
        int dev = 0, cus = 0, per_cu = 0;
        if (hipGetDevice(&dev) != hipSuccess || hipDeviceGetAttribute(&cus, hipDeviceAttributeMultiprocessorCount, dev) != hipSuccess) { grid = -1; return; }
        if (hipFuncSetAttribute((const void*)mk_fwd, hipFuncAttributeMaxDynamicSharedMemorySize, LDS_BYTES) != hipSuccess) { fprintf(stderr, "kernel_launch: hipFuncSetAttribute failed\n"); grid = -1; return; }
        if (hipOccupancyMaxActiveBlocksPerMultiprocessor(&per_cu, (const void*)mk_fwd, 512, LDS_BYTES) != hipSuccess || per_cu < 1) fprintf(stderr, "kernel_launch: occupancy query says %d\n", per_cu);
        (void)hipGetLastError();
        grid = cus;
        if (grid != 256) { fprintf(stderr, "kernel_launch: built for 256 CUs, found %d\n", cus); grid = -1; return; }
    }
    if (grid < 0) return;
    (void)hipMemsetAsync((char*)d_ws + WS_CTL, 0, CTL_ZERO_BYTES, stream);
    Args a{};
    for (int i = 0; i < 25; ++i) a.in[i] = (const float*)d_in[i];
    a.out = (float*)d_out; a.ws = (unsigned char*)d_ws;
    for (int h = 0; h < 16; ++h) a.lg2g[h] = (float)(log1p(-exp2(-5.0 - (double)h)) / log(2.0));
    constexpr int NPH = 7;
    if (MK_N_LAUNCHES == 1) { a.ph_lo = 0; a.ph_hi = NPH; hipLaunchKernelGGL(mk_fwd, dim3(grid), dim3(512), LDS_BYTES, stream, a); }
    else for (int p = 0; p < NPH; ++p) { a.ph_lo = p; a.ph_hi = p + 1; hipLaunchKernelGGL(mk_fwd, dim3(grid), dim3(512), LDS_BYTES, stream, a); }
}
```

```cpp
#include <hip/hip_runtime.h>
#include <cstdio>
#include <cstdint>
#include <cmath>

#ifndef REP_P0
#define REP_P0 1
#endif
#ifndef REP_P1
#define REP_P1 1
#endif
#ifndef REP_P2
#define REP_P2 1
#endif
#ifndef REP_RP
#define REP_RP REP_P2
#endif
#ifndef REP_XP
#define REP_XP REP_P2
#endif
#ifndef REP_SP
#define REP_SP REP_P2
#endif
#ifndef REP_SS
#define REP_SS REP_P2
#endif
#ifndef REP_XS
#define REP_XS REP_P2
#endif
#ifndef REP_RS
#define REP_RS REP_P2
#endif
#ifndef MK_N_LAUNCHES
#define MK_N_LAUNCHES 1
#endif

#define LAS __attribute__((address_space(3)))
typedef unsigned short bf16_t;
typedef short bf16x8 __attribute__((ext_vector_type(8)));
typedef float f32x4 __attribute__((ext_vector_type(4)));
typedef float f32x16 __attribute__((ext_vector_type(16)));
typedef unsigned u32x4 __attribute__((ext_vector_type(4)));
typedef unsigned u32x2 __attribute__((ext_vector_type(2)));

constexpr int DM = 4096, TP = 8192, TS = 1024, TT = 9216;
#ifndef LDPAD
#define LDPAD 64
#endif
constexpr int ZLD = 32768 + LDPAD, ALD = 8192 + LDPAD, LDX = 4096 + LDPAD, LDG = 2048 + LDPAD;
constexpr int LD8 = 4096 + 128, LDA8 = 8192 + 128;
constexpr int LDM8 = 12288 + 128;
constexpr int LDG8 = 2048 + 128;
constexpr float ACS = 8.f;
constexpr int ZQ = 0, ZK = 2048, ZV = 4096, ZGR = 8192, ZU = 12288, ZGS = 14336, ZQX = 16384, ZGX = 18432, ZMA = 20480;
constexpr int AC_RET = 0, AC_S5 = 4096, AC_X = 6144;
constexpr float DN_ALPHA = 1.189207115002721f;
constexpr size_t O_YP = 0, O_YS = 33554432, O_RETP = 37748736, O_S5RP = 39845888, O_S5IP = 39878656, O_MK = 39911424, O_MV = 42008576,
                 O_RETS = 44105728, O_S5RS = 111214592, O_S5IS = 112263168, O_END = 113311744;
constexpr size_t MiB = 1u << 20;
constexpr size_t WS_CTL = 0, CTL_ZERO_BYTES = 262144;
constexpr size_t WS_XB = 1 * MiB, WS_MEMB = 75 * MiB, WS_WIN = 84 * MiB, WS_WMKV = 344 * MiB, WS_WGLU = 377 * MiB, WS_WCAT = 394 * MiB, WS_WOUT = 459 * MiB,
                 WS_Z = 492 * MiB, WS_ACAT = 1070 * MiB, WS_GL = 1216 * MiB, WS_MERGED = 1254 * MiB, WS_KVB = 1328 * MiB, WS_ROPE = 1336 * MiB, WS_S5 = 1338 * MiB,
                 WS_SLAB = 1340 * MiB, WS_XB8 = 1404 * MiB, WS_ZM8 = 1444 * MiB, WS_END = 1554 * MiB;
constexpr size_t WS_WINB = WS_WIN, WS_WIN8 = WS_WIN + 70 * MiB;
static_assert(WS_WINB + (size_t)8192 * LDX * 2 <= WS_WIN8 && WS_WIN8 + (size_t)24576 * LD8 <= WS_WMKV && WS_XB8 + (size_t)TT * LD8 <= WS_ZM8 && WS_ZM8 + (size_t)TT * LDM8 <= WS_END, "d_ws map (fp8)");
static_assert(WS_XB + (size_t)TT * LDX * 2 <= WS_MEMB && WS_MEMB + (size_t)1024 * LDX * 2 <= WS_WIN && WS_WIN + (size_t)32768 * LDX * 2 <= WS_WMKV && WS_WMKV + (size_t)4096 * LDX * 2 <= WS_WGLU &&
              WS_WGLU + (size_t)4096 * LDG * 2 <= WS_WCAT && WS_WCAT + (size_t)4096 * ALD * 2 <= WS_WOUT && WS_WOUT + (size_t)4096 * LDX * 2 <= WS_Z && WS_Z + (size_t)TT * ZLD * 2 <= WS_ACAT &&
              WS_ACAT + (size_t)TT * ALD * 2 <= WS_GL && WS_GL + (size_t)TT * LDG * 2 <= WS_MERGED && WS_MERGED + (size_t)TT * LDX * 2 <= WS_KVB, "d_ws map");
constexpr size_t S5_ABAR = 0, S5_BFRAG = 65536, S5_CFRAG = 65536 + 524288;
constexpr int CW_QUEUE = 64, CW_BAR = 4096, CW_TICKET = 16384;
constexpr int LDS_BYTES = 147456;

__device__ __forceinline__ float bf2f(unsigned short b) { return __uint_as_float(((unsigned)b) << 16); }
__device__ __forceinline__ unsigned short f2bf(float f) { unsigned u = __float_as_uint(f); return (unsigned short)((u + 0x7fffu + ((u >> 16) & 1u)) >> 16); }
__device__ __forceinline__ unsigned cvt_pk_bf16(float lo, float hi) { unsigned r; asm volatile("v_cvt_pk_bf16_f32 %0, %1, %2" : "=v"(r) : "v"(lo), "v"(hi)); return r; }
__device__ __forceinline__ float sat8(float v) { return __builtin_amdgcn_fmed3f(v, -448.f, 448.f); }
__device__ __forceinline__ unsigned pk4_fp8(float a, float b, float c, float d) { unsigned w = 0u; w = __builtin_amdgcn_cvt_pk_fp8_f32(sat8(a), sat8(b), w, false); w = __builtin_amdgcn_cvt_pk_fp8_f32(sat8(c), sat8(d), w, true); return w; }
__device__ __forceinline__ u32x2 pk8_fp8(const f32x4 a, const f32x4 b, float sc) {
    unsigned w0 = 0u, w1 = 0u;
    w0 = __builtin_amdgcn_cvt_pk_fp8_f32(a[0] * sc, a[1] * sc, w0, false); w0 = __builtin_amdgcn_cvt_pk_fp8_f32(a[2] * sc, a[3] * sc, w0, true);
    w1 = __builtin_amdgcn_cvt_pk_fp8_f32(b[0] * sc, b[1] * sc, w1, false); w1 = __builtin_amdgcn_cvt_pk_fp8_f32(b[2] * sc, b[3] * sc, w1, true);
    u32x2 o; o.x = w0; o.y = w1; return o; }
__device__ __forceinline__ u32x2 bf8_to_fp8(const u32x4 v, float sc) {
    u32x2 o; o.x = pk4_fp8(__uint_as_float(v.x << 16) * sc, __uint_as_float(v.x & 0xffff0000u) * sc, __uint_as_float(v.y << 16) * sc, __uint_as_float(v.y & 0xffff0000u) * sc);
    o.y = pk4_fp8(__uint_as_float(v.z << 16) * sc, __uint_as_float(v.z & 0xffff0000u) * sc, __uint_as_float(v.w << 16) * sc, __uint_as_float(v.w & 0xffff0000u) * sc); return o; }
__device__ __forceinline__ unsigned pk4_u8(float a, float b, float c, float d) {
    unsigned w = 0u; w = __builtin_amdgcn_cvt_pk_u8_f32(a, 0, w); w = __builtin_amdgcn_cvt_pk_u8_f32(b, 1, w); w = __builtin_amdgcn_cvt_pk_u8_f32(c, 2, w); w = __builtin_amdgcn_cvt_pk_u8_f32(d, 3, w); return w; }
__device__ __forceinline__ float ub(unsigned w, int k) { return (float)((w >> (8 * k)) & 0xffu); }
__device__ __forceinline__ float fast_rcp(float x) { return __builtin_amdgcn_rcpf(x); }
constexpr float GSC = 16.f;
typedef float f32x2_ __attribute__((ext_vector_type(2)));
__device__ __forceinline__ const unsigned char* gate8(const bf16_t* Z, size_t row, int G, int c) { return (const unsigned char*)(Z + row * ZLD + G) + c; }
__device__ __forceinline__ void unpack4_fp8(unsigned w, float (&g)[4]) { const f32x2_ a = __builtin_amdgcn_cvt_pk_f32_fp8((int)w, false), b = __builtin_amdgcn_cvt_pk_f32_fp8((int)w, true); g[0] = a[0]; g[1] = a[1]; g[2] = b[0]; g[3] = b[1]; }
__device__ __forceinline__ void unpack8_fp8(u32x2 w, float (&g)[8]) { float lo[4], hi[4]; unpack4_fp8(w.x, lo); unpack4_fp8(w.y, hi);
    g[0] = lo[0]; g[1] = lo[1]; g[2] = lo[2]; g[3] = lo[3]; g[4] = hi[0]; g[5] = hi[1]; g[6] = hi[2]; g[7] = hi[3]; }
__device__ __forceinline__ float silu_f(float x) { return x * fast_rcp(1.0f + __expf(-x)); }
__device__ __forceinline__ float sigmoid_f(float x) { x = fminf(fmaxf(x, -30.f), 30.f); return fast_rcp(1.0f + __expf(-x)); }
__device__ __forceinline__ float gelu_tanh_f(float x) { const float z = 0.7978845608028654f * (x + 0.044715f * x * x * x); const float t = 1.0f - 2.0f * fast_rcp(1.0f + __expf(2.0f * z)); return 0.5f * x * (1.0f + t); }
__device__ __forceinline__ float wave_sum(float v) {
#pragma unroll
    for (int o = 1; o < 64; o <<= 1) v += __shfl_xor(v, o);
    return v;
}
__device__ __forceinline__ float wave_max(float v) {
#pragma unroll
    for (int o = 1; o < 64; o <<= 1) v = fmaxf(v, __shfl_xor(v, o));
    return v;
}
template <class T> __device__ __forceinline__ T* opq(T* p) { asm volatile("" : "+v"(p)); return p; }
template <class T> __device__ __forceinline__ LAS T* opq(LAS T* p) { asm volatile("" : "+v"(p)); return p; }
#define GAS __attribute__((address_space(1)))
template <class T> __device__ __forceinline__ GAS T* opqg(T* p) { asm volatile("" : "+v"(p)); return (GAS T*)p; }
template <int CTRL> __device__ __forceinline__ float dpp_mov(float v) { return __builtin_bit_cast(float, __builtin_amdgcn_update_dpp(0, __builtin_bit_cast(int, v), CTRL, 0xf, 0xf, true)); }
__device__ __forceinline__ float row16_sum(float v) { v += dpp_mov<0xB1>(v); v += dpp_mov<0x4E>(v); v += dpp_mov<0x141>(v); v += dpp_mov<0x140>(v); return v; }
__device__ __forceinline__ float row16_max(float v) { v = fmaxf(v, dpp_mov<0xB1>(v)); v = fmaxf(v, dpp_mov<0x4E>(v)); v = fmaxf(v, dpp_mov<0x141>(v)); v = fmaxf(v, dpp_mov<0x140>(v)); return v; }
__device__ __forceinline__ f32x4 mfma16(bf16x8 a, bf16x8 b, f32x4 c) { return __builtin_amdgcn_mfma_f32_16x16x32_bf16(a, b, c, 0, 0, 0); }

#define XB_TMO      128
#define XB_XCNT(j)  (256  + 64 * (j))
#define XB_XSUB(j)  (1280 + 64 * (j))
#define XB_XGEN(j)  (2304 + 64 * (j))
#define XB_TOP      3328
#define XB_TOPGEN   3392
#define XCD_BAR_WORDS 3456
#define XB_SPIN_CAP (1u << 18)
__device__ __forceinline__ unsigned xb_ld(unsigned* p)              { return __hip_atomic_load(p, __ATOMIC_RELAXED, __HIP_MEMORY_SCOPE_AGENT); }
__device__ __forceinline__ unsigned xb_add(unsigned* p, unsigned v) { return __hip_atomic_fetch_add(p, v, __ATOMIC_RELAXED, __HIP_MEMORY_SCOPE_AGENT); }
__device__ __forceinline__ unsigned xb_xcc_id() { return (unsigned)__builtin_amdgcn_s_getreg((3 << 11) | 20) & 0xFu; }
#define XB_SPIN(cond, bar) do { unsigned _sp = 0; while (cond) { __builtin_amdgcn_s_sleep(1); \
    if ((++_sp & 255u) == 0u) { if (xb_ld(&(bar)[XB_TMO])) break; if (_sp > XB_SPIN_CAP) { atomicAdd(&(bar)[XB_TMO], 1u); break; } } } } while (0)
struct XcdBarrier { unsigned* bar; unsigned x; volatile LAS unsigned* st; };
__device__ __forceinline__ XcdBarrier xcd_barrier_post(unsigned* bar, volatile LAS unsigned* st) {
    XcdBarrier b; b.bar = bar; b.x = xb_xcc_id(); b.st = st;
    if (threadIdx.x == 0) (void)xb_add(&bar[XB_XCNT(b.x)], 1u);
    return b;
}
__device__ __forceinline__ void xcd_barrier_complete(unsigned* bar, unsigned x, unsigned& nloc, unsigned& nx) {
    const unsigned G = gridDim.x * gridDim.y * gridDim.z;
    unsigned sum, cnt, mine, sp = 0u;
    for (;;) {
        sum = 0u; cnt = 0u; mine = 0u;
#pragma unroll
        for (unsigned j = 0; j < 16; ++j) { const unsigned c = xb_ld(&bar[XB_XCNT(j)]); sum += c; cnt += (c > 0u) ? 1u : 0u; mine = (j == x) ? c : mine; }
        if (sum == G) break;
        __builtin_amdgcn_s_sleep(1);
        if ((++sp & 255u) == 0u) { if (xb_ld(&bar[XB_TMO])) break; if (sp > XB_SPIN_CAP) { atomicAdd(&bar[XB_TMO], 1u); break; } }
    }
    nloc = mine > 0u ? mine : 1u; nx = cnt > 0u ? cnt : 1u;
}
__device__ __forceinline__ void xcd_barrier(const XcdBarrier& b) {
    asm volatile("s_waitcnt vmcnt(0)" ::: "memory");
    __syncthreads();
    if (threadIdx.x == 0) {
        unsigned* bar = b.bar;
        __builtin_amdgcn_s_waitcnt(0);
        unsigned nloc = b.st[0], nx = b.st[1];
        if (nloc == 0u) { xcd_barrier_complete(bar, b.x, nloc, nx); b.st[0] = nloc; b.st[1] = nx; }
        const unsigned old = xb_add(&bar[XB_XSUB(b.x)], 1u);
        const unsigned gen = old / nloc;
        if (old + 1u == (gen + 1u) * nloc) {
            __builtin_amdgcn_fence(__ATOMIC_RELEASE, "agent");
            asm volatile("s_waitcnt vmcnt(0)" ::: "memory");
            const unsigned og = xb_add(&bar[XB_TOP], 1u);
            const unsigned tg = og / nx;
            if (og + 1u == (tg + 1u) * nx) xb_add(&bar[XB_TOPGEN], 1u);
            else XB_SPIN(xb_ld(&bar[XB_TOPGEN]) == tg, bar);
            __builtin_amdgcn_fence(__ATOMIC_ACQUIRE, "agent");
            xb_add(&bar[XB_XGEN(b.x)], 1u);
            asm volatile("s_waitcnt vmcnt(0)" ::: "memory");
        } else {
            XB_SPIN(xb_ld(&bar[XB_XGEN(b.x)]) == gen, bar);
            __builtin_amdgcn_fence(__ATOMIC_ACQUIRE, "agent");
            asm volatile("s_waitcnt vmcnt(0)" ::: "memory");
        }
    }
    __syncthreads();
}

namespace pg8 {
constexpr int BM = 256, BK = 64, HALF = 128, HTB = HALF * BK * 2, STAGE_BYTES = 8 * HTB, NXCD = 8, WGM = 8;
__host__ __device__ __forceinline__ int lds_byte(int r, int c) { const int st = (r >> 4) * 2 + (c >> 5), rr = r & 15, cc = c & 31, ob = rr * 64 + cc * 2; return st * 1024 + (ob ^ (((ob >> 9) & 1) << 5)); }
__host__ __device__ __forceinline__ void stage_rc(int b, int& R, int& C) { const int st = b / 1024, sb = b % 1024, swz = sb ^ (((sb >> 9) & 1) << 5); R = (st >> 1) * 16 + swz / 64; C = (st & 1) * 32 + (swz % 64) / 2; }
__host__ __device__ __forceinline__ int perm32(int rho) { const int n = rho >> 4, i = rho & 15; return 8 * (i >> 2) + 4 * n + (i & 3); }
struct Unit { int pm, pn; };
struct Gemm { const bf16_t* A; const bf16_t* Bt; int M, N, K, lda, ldb; int sc = 0x7f78; };
struct StaticOrder {
    int nM, nN, nwg, G, c;
    __host__ __device__ void init(int M, int N, int G_, int c_) { nM = M / BM; nN = N / BM; nwg = nM * nN; G = G_; c = c_; }
    __host__ __device__ bool next(int i, Unit& u) const {
        const long L = (long)i * G + c; if (L >= nwg) return false;
        int wgid = (int)L; { const int q = nwg / NXCD, r = nwg % NXCD, xcd = wgid % NXCD, off = wgid / NXCD; wgid = (xcd < r ? xcd * (q + 1) : r * (q + 1) + (xcd - r) * q) + off; }
        const int nig = WGM * nN, gid = wgid / nig, fm = gid * WGM, gsz = (nM - fm) < WGM ? (nM - fm) : WGM;
        u.pm = fm + ((wgid % nig) % gsz); u.pn = (wgid % nig) / gsz; return true;
    }
    __device__ __forceinline__ void a_ready(const Unit&) const {}
    __device__ __forceinline__ void done(const Unit&) const {}
};
template <class Epi, class Sched, bool ALIGN_EPI = false, bool SP2 = false, bool F8 = false>
__device__ __forceinline__ void gemm_phase(LAS unsigned char* lds, const Gemm g, const Sched& S, const Epi& E) {
    const int tid = threadIdx.x, wid = __builtin_amdgcn_readfirstlane(tid >> 6), lane = tid & 63, wr = wid >> 2, wc = wid & 3, fr = lane & 15, fq = lane >> 4;
    const int K = g.K, nt = K / BK;
    unsigned voffA[2], voffB[2];
#pragma unroll
    for (int i = 0; i < 2; ++i) { int R, C; stage_rc(tid * 16 + i * 8192, R, C); const int Rb = Epi::WIDE ? ((R >> 5) * 64 + perm32(R & 31)) : (Epi::PERM ? ((R & ~31) + perm32(R & 31)) : R);
        voffA[i] = (unsigned)(R * g.lda + C) * 2u; voffB[i] = (unsigned)(Rb * g.ldb + C) * 2u; }
    const size_t kstep = (size_t)(BK * 2);
    const size_t hstepA = (size_t)HALF * g.lda * 2, hstepB = (size_t)(Epi::WIDE ? 32 : HALF) * g.ldb * 2;
    const size_t tstepA = 2 * hstepA, tstepB = (size_t)2 * HALF * g.ldb * 2;
    const unsigned ldsw = (unsigned)wid * 1024u;
    const int aoff = lds_byte(wr * 64 + fr, fq * 8), boff = lds_byte(wc * 32 + fr, fq * 8);
#define PG8_SA(b, h) (((b) * 2 + (h)) * HTB)
#define PG8_SB(b, h) ((4 + (b) * 2 + (h)) * HTB)
#define PG8_STAGE(bufoff, gbase, voff) do { _Pragma("unroll") for (int _i = 0; _i < 2; ++_i) \
        __builtin_amdgcn_global_load_lds((const unsigned*)((const char*)(gbase) + (voff)[_i]), (LAS unsigned*)(lds + (bufoff) + ldsw + _i * 8192), 16, 0, 0); } while (0)
#define PG8_LDA(dst, b, h) do { _Pragma("unroll") for (int m = 0; m < 4; ++m) { if constexpr (F8) { const v4i_ lo_ = *(const LAS v4i_*)(lds + PG8_SA(b, h) + aoff + m * 2048), hi_ = *(const LAS v4i_*)(lds + PG8_SA(b, h) + aoff + m * 2048 + 1024); \
            dst##8[m] = __builtin_shufflevector(lo_, hi_, 0, 1, 2, 3, 4, 5, 6, 7); } else { _Pragma("unroll") for (int k = 0; k < 2; ++k) dst[m][k] = *(const LAS bf16x8*)(lds + PG8_SA(b, h) + aoff + m * 2048 + k * 1024); } } } while (0)
#define PG8_LDB(dst, b, h) do { _Pragma("unroll") for (int n = 0; n < 2; ++n) { if constexpr (F8) { const v4i_ lo_ = *(const LAS v4i_*)(lds + PG8_SB(b, h) + boff + n * 2048), hi_ = *(const LAS v4i_*)(lds + PG8_SB(b, h) + boff + n * 2048 + 1024); \
            dst##8[n] = __builtin_shufflevector(lo_, hi_, 0, 1, 2, 3, 4, 5, 6, 7); } else { _Pragma("unroll") for (int k = 0; k < 2; ++k) dst[n][k] = *(const LAS bf16x8*)(lds + PG8_SB(b, h) + boff + n * 2048 + k * 1024); } } } while (0)
#define PG8_MMA(ai, bj, At, Bt) do { __builtin_amdgcn_s_setprio(1); _Pragma("unroll") for (int m = 0; m < 4; ++m) _Pragma("unroll") for (int n = 0; n < 2; ++n) { \
        if constexpr (F8) asm volatile("v_mfma_scale_f32_16x16x128_f8f6f4 %0, %1, %2, %0, %3, %3 op_sel:[0,1,0] op_sel_hi:[0,0,0]" : "+v"(acc[ai][bj][m][n]) : "v"(Bt##8[n]), "v"(At##8[m]), "v"(f8_sc)); \
        else { _Pragma("unroll") for (int k = 0; k < 2; ++k) acc[ai][bj][m][n] = __builtin_amdgcn_mfma_f32_16x16x32_bf16(Bt[n][k], At[m][k], acc[ai][bj][m][n], 0, 0, 0); } } \
        __builtin_amdgcn_s_setprio(0); } while (0)
#define PG8_WAIT_V(n) asm volatile("s_waitcnt vmcnt(" #n ")" ::: "memory")
#define PG8_WAIT_L(n) asm volatile("s_waitcnt lgkmcnt(" #n ")" ::: "memory")
#define PG8_BAR __builtin_amdgcn_s_barrier()
#define PG8_SCHED __builtin_amdgcn_sched_barrier(0)
    Unit cur, nxt; int ui = 0;
    if (!S.next(0, cur)) return;
    f32x4 acc[2][2][4][2];
#pragma unroll
    for (int a = 0; a < 2; ++a)
#pragma unroll
        for (int b = 0; b < 2; ++b)
#pragma unroll
            for (int m = 0; m < 4; ++m)
#pragma unroll
                for (int n = 0; n < 2; ++n) acc[a][b][m][n] = (f32x4){0.f, 0.f, 0.f, 0.f};
    typedef int v8i_ __attribute__((ext_vector_type(8))); typedef int v4i_ __attribute__((ext_vector_type(4)));
    bf16x8 At[4][2], B0[2][2], B1[2][2]; v8i_ At8[4], B08[2], B18[2];
    const int f8_sc = g.sc;
    const char* cA = (const char*)g.A + (size_t)cur.pm * tstepA; const char* cB = (const char*)g.Bt + (size_t)cur.pn * tstepB;
    S.a_ready(cur);
    if constexpr (SP2) {
        PG8_STAGE(PG8_SB(0, 0), cB, voffB); PG8_STAGE(PG8_SB(0, 1), cB + hstepB, voffB); PG8_STAGE(PG8_SA(0, 0), cA, voffA); PG8_STAGE(PG8_SA(0, 1), cA + hstepA, voffA);
        if (wr == 1) PG8_BAR;
        PG8_WAIT_V(2); PG8_BAR;
        PG8_STAGE(PG8_SB(1, 0), cB + kstep, voffB); PG8_STAGE(PG8_SA(1, 0), cA + kstep, voffA); PG8_STAGE(PG8_SB(1, 1), cB + hstepB + kstep, voffB);
        PG8_WAIT_V(6); PG8_BAR;
    } else {
        PG8_STAGE(PG8_SB(0, 0), cB, voffB); PG8_STAGE(PG8_SA(0, 0), cA, voffA); PG8_STAGE(PG8_SB(0, 1), cB + hstepB, voffB); PG8_STAGE(PG8_SA(0, 1), cA + hstepA, voffA);
        if (wr == 1) PG8_BAR;
        PG8_WAIT_V(4); PG8_BAR;
        PG8_STAGE(PG8_SB(1, 0), cB + kstep, voffB); PG8_STAGE(PG8_SA(1, 0), cA + kstep, voffA); PG8_STAGE(PG8_SB(1, 1), cB + hstepB + kstep, voffB);
        PG8_WAIT_V(6); PG8_BAR;
    }
    for (;;) {
        const bool has_next = S.next(ui + 1, nxt);
        const char* nA = has_next ? (const char*)g.A + (size_t)nxt.pm * tstepA : cA; const char* nB = has_next ? (const char*)g.Bt + (size_t)nxt.pn * tstepB : cB;
        int tb_ = 0;
#pragma unroll 1
        for (int seg = 0; seg < (Epi::MID ? 3 : 1); ++seg) {
        const int te_ = Epi::MID ? (seg == 0 ? Epi::MID_T1 : (seg == 1 ? Epi::MID_T2 : nt)) : nt;
#pragma unroll 1
        for (int t = tb_; t < te_; t += 2) {
            const bool last = (t == nt - 2);
            const char* a1 = cA + (size_t)(t + 1) * kstep;
            const char* a2 = last ? nA : cA + (size_t)(t + 2) * kstep; const char* b2 = last ? nB : cB + (size_t)(t + 2) * kstep;
            const char* a3 = a2 + kstep; const char* b3 = b2 + kstep;
            if (last && has_next) S.a_ready(nxt);
            if constexpr (SP2) {
            PG8_LDB(B0, 0, 0); PG8_LDB(B1, 0, 1); PG8_SCHED; PG8_LDA(At, 0, 0); PG8_STAGE(PG8_SA(1, 1), a1 + hstepA, voffA);
            PG8_WAIT_V(8); PG8_WAIT_L(0); PG8_BAR; PG8_MMA(0, 0, At, B0); PG8_MMA(0, 1, At, B1); PG8_BAR; PG8_SCHED;
            PG8_LDA(At, 0, 1); PG8_STAGE(PG8_SB(0, 0), b2, voffB); PG8_STAGE(PG8_SB(0, 1), b2 + hstepB, voffB); PG8_STAGE(PG8_SA(0, 0), a2, voffA);
            PG8_WAIT_V(8); PG8_WAIT_L(0); PG8_BAR; PG8_MMA(1, 0, At, B0); PG8_MMA(1, 1, At, B1); PG8_BAR; PG8_SCHED;
            PG8_LDB(B0, 1, 0); PG8_LDB(B1, 1, 1); PG8_SCHED; PG8_LDA(At, 1, 0); PG8_STAGE(PG8_SA(0, 1), a2 + hstepA, voffA);
            PG8_WAIT_V(8); PG8_WAIT_L(0); PG8_BAR; PG8_MMA(0, 0, At, B0); PG8_MMA(0, 1, At, B1); PG8_BAR; PG8_SCHED;
            PG8_LDA(At, 1, 1); PG8_STAGE(PG8_SB(1, 0), b3, voffB); PG8_STAGE(PG8_SB(1, 1), b3 + hstepB, voffB); PG8_STAGE(PG8_SA(1, 0), a3, voffA);
            PG8_WAIT_V(8); PG8_WAIT_L(0); PG8_BAR; PG8_MMA(1, 0, At, B0); PG8_MMA(1, 1, At, B1); PG8_BAR; PG8_SCHED;
            } else {
            PG8_LDB(B0, 0, 0); PG8_SCHED; PG8_LDA(At, 0, 0); PG8_STAGE(PG8_SA(1, 1), a1 + hstepA, voffA);
            PG8_WAIT_L(8); PG8_BAR; PG8_WAIT_L(0); PG8_MMA(0, 0, At, B0); PG8_BAR; PG8_SCHED;
            PG8_LDB(B1, 0, 1); PG8_STAGE(PG8_SB(0, 0), b2, voffB);
            PG8_BAR; PG8_WAIT_L(0); PG8_MMA(0, 1, At, B1); PG8_BAR;
            PG8_LDA(At, 0, 1); PG8_STAGE(PG8_SA(0, 0), a2, voffA);
            PG8_BAR; PG8_WAIT_L(0); PG8_MMA(1, 0, At, B0); PG8_BAR; PG8_SCHED;
            PG8_STAGE(PG8_SB(0, 1), b2 + hstepB, voffB);
            PG8_WAIT_V(6); PG8_BAR; PG8_MMA(1, 1, At, B1); PG8_BAR;
            PG8_LDB(B0, 1, 0); PG8_SCHED; PG8_LDA(At, 1, 0); PG8_STAGE(PG8_SA(0, 1), a2 + hstepA, voffA);
            PG8_WAIT_L(8); PG8_BAR; PG8_WAIT_L(0); PG8_MMA(0, 0, At, B0); PG8_BAR; PG8_SCHED;
            PG8_LDB(B1, 1, 1); PG8_STAGE(PG8_SB(1, 0), b3, voffB);
            PG8_BAR; PG8_WAIT_L(0); PG8_MMA(0, 1, At, B1); PG8_BAR;
            PG8_LDA(At, 1, 1); PG8_STAGE(PG8_SA(1, 0), a3, voffA);
            PG8_BAR; PG8_WAIT_L(0); PG8_MMA(1, 0, At, B0); PG8_BAR; PG8_SCHED;
            PG8_STAGE(PG8_SB(1, 1), b3 + hstepB, voffB);
            PG8_WAIT_V(6); PG8_BAR; PG8_MMA(1, 1, At, B1); PG8_BAR;
            }
        }
        if constexpr (Epi::MID) { if (seg < 2) { if constexpr (F8) asm volatile("s_nop 15\n\ts_nop 7" ::: "memory"); E.mid(acc, cur, wr, wc, fr, fq, seg); } }
        tb_ = te_;
        }
        if constexpr (ALIGN_EPI) { if (wr == 0) PG8_BAR; }
        if constexpr (F8) asm volatile("s_nop 15\n\ts_nop 7" ::: "memory");
        if constexpr (!Epi::AFTER_DRAIN) { E(acc, cur, wr, wc, fr, fq); S.done(cur); }
        if (!has_next) break;
#pragma unroll
        for (int a = 0; a < 2; ++a)
#pragma unroll
            for (int b = 0; b < 2; ++b)
#pragma unroll
                for (int m = 0; m < 4; ++m)
#pragma unroll
                    for (int n = 0; n < 2; ++n) acc[a][b][m][n] = (f32x4){0.f, 0.f, 0.f, 0.f};
        cur = nxt; cA = nA; cB = nB; ++ui;
        if constexpr (ALIGN_EPI) { if (wr == 1) PG8_BAR; }
    }
    PG8_WAIT_V(0);
    if constexpr (!ALIGN_EPI) { if (wr == 0) PG8_BAR; }
    PG8_BAR;
    if constexpr (Epi::AFTER_DRAIN) { E.fused(acc, cur, wr, wc, fr, fq, lds); S.done(cur); }
#undef PG8_SA
#undef PG8_SB
#undef PG8_STAGE
#undef PG8_LDA
#undef PG8_LDB
#undef PG8_MMA
#undef PG8_WAIT_V
#undef PG8_WAIT_L
#undef PG8_BAR
#undef PG8_SCHED
}
}
#ifndef PG8_SP2
#define PG8_SP2 true
#endif
#ifndef PG8_ALIGN
#define PG8_ALIGN true
#endif
using pg8::Unit;

struct EpiZ {
    static constexpr bool PERM = true, WIDE = true, MID = false, AFTER_DRAIN = false; static constexpr int MID_T1 = -1, MID_T2 = -1;
    __device__ __forceinline__ void pre(f32x4 (&)[2][2][4][2], const Unit&, int, int, int, int, int) const {}
    bf16_t* Z; const float* rope; const float* lg2g; int seg; unsigned char* zm8;
    __device__ __forceinline__ void mid(f32x4 (&)[2][2][4][2], const Unit&, int, int, int, int, int) const {}
    __device__ __forceinline__ void operator()(const f32x4 (&acc)[2][2][4][2], const Unit& u, int wr, int wc, int fr, int fq) const {
        const int pn = (seg == 1) ? (u.pn < 24 ? u.pn + 8 : u.pn + 24) : (u.pn < 8 ? u.pn : (u.pn < 24 ? u.pn + 24 : u.pn + 32));
        const int row0 = u.pm * 256 + wr * 64 + fr, col0 = pn * 256 + wc * 64 + 8 * fq;
        GAS bf16_t* zb = opqg(Z + (size_t)row0 * ZLD + col0); const GAS unsigned* ropeb = opqg((const unsigned*)rope + (32 * (wc & 1) + 4 * fq));
        int mode;
        float sc = 1.f;
        if (pn < 8) mode = 3; else if (pn < 16) mode = 4; else if (pn < 32) mode = 0; else if (pn < 48) mode = 1; else if (pn < 56) mode = 0; else if (pn < 64) mode = 1;
        else if (pn < 72) { mode = 0; sc = 0.04419417382415922f; } else if (pn < 80) mode = 1; else mode = 2;
        if (mode >= 3) {
            const float ksc = (mode == 4) ? 0.08838834764831845f : 1.0f; const float sgn = (mode == 4) ? -1.0f : 1.0f;
            const int h = (2 * pn + (wc >> 1)) & 15;
            u32x4 rw[16];
#pragma unroll
            for (int ai = 0; ai < 2; ++ai)
#pragma unroll
                for (int m = 0; m < 4; ++m) { const int row = row0 + ai * 128 + m * 16; const int prow = row < TP ? (row & 2047) : 2048 + (row & 7);
                    const GAS u32x4* rp = (const GAS u32x4*)(ropeb + (size_t)prow * 64);
                    rw[(ai * 4 + m) * 2] = rp[0]; rw[(ai * 4 + m) * 2 + 1] = rp[4]; }
#pragma unroll
            for (int ai = 0; ai < 2; ++ai)
#pragma unroll
                for (int m = 0; m < 4; ++m) {
                    const int row = row0 + ai * 128 + m * 16;
                    const float ip1 = (float)((row < TP ? (row & 63) : (row & 7)) + 1);
                    const float f = exp2f(sgn * lg2g[h] * ip1) * ksc;
                    GAS bf16_t* rowp = zb + (size_t)(ai * 128 + m * 16) * ZLD;
#pragma unroll
                    for (int bj = 0; bj < 2; ++bj) {
                        const u32x4 w4 = rw[(ai * 4 + m) * 2 + bj];
                        const f32x4 r0 = {__uint_as_float(w4.x << 16), __uint_as_float(w4.x & 0xffff0000u), __uint_as_float(w4.y << 16), __uint_as_float(w4.y & 0xffff0000u)};
                        const f32x4 r1 = {__uint_as_float(w4.z << 16), __uint_as_float(w4.z & 0xffff0000u), __uint_as_float(w4.w << 16), __uint_as_float(w4.w & 0xffff0000u)};
                        const f32x4 v0 = acc[ai][bj][m][0], v1 = acc[ai][bj][m][1];
                        float o0 = (v0[0] * r0[0] - v0[1] * r0[1]) * f, o1 = (v0[0] * r0[1] + v0[1] * r0[0]) * f;
                        float o2 = (v0[2] * r0[2] - v0[3] * r0[3]) * f, o3 = (v0[2] * r0[3] + v0[3] * r0[2]) * f;
                        float o4 = (v1[0] * r1[0] - v1[1] * r1[1]) * f, o5 = (v1[0] * r1[1] + v1[1] * r1[0]) * f;
                        float o6 = (v1[2] * r1[2] - v1[3] * r1[3]) * f, o7 = (v1[2] * r1[3] + v1[3] * r1[2]) * f;
                        u32x4 w; w.x = cvt_pk_bf16(o0, o1); w.y = cvt_pk_bf16(o2, o3); w.z = cvt_pk_bf16(o4, o5); w.w = cvt_pk_bf16(o6, o7);
                        __builtin_nontemporal_store(w, (GAS u32x4*)(rowp + bj * 32));
                    }
                }
        } else {
#pragma unroll
            for (int ai = 0; ai < 2; ++ai)
#pragma unroll
                for (int m = 0; m < 4; ++m) {
                    GAS bf16_t* rowp = zb + (size_t)(ai * 128 + m * 16) * ZLD;
#pragma unroll
                    for (int bj = 0; bj < 2; ++bj) {
                        f32x4 v0 = acc[ai][bj][m][0], v1 = acc[ai][bj][m][1];
                        if (mode == 0) { v0 = v0 * sc; v1 = v1 * sc; }
                        else if (mode == 1) {
#pragma unroll
                            for (int j = 0; j < 4; ++j) { v0[j] = silu_f(v0[j]); v1[j] = silu_f(v1[j]); }
                            const int G = pn < 48 ? ZGR : (pn < 64 ? ZGS : ZGX);
                            *(u32x2*)((unsigned char*)(Z + (size_t)(row0 + ai * 128 + m * 16) * ZLD + G) + (pn * 256 - G) + wc * 64 + 8 * fq + bj * 32) = pk8_fp8(v0, v1, GSC); continue;
                        } else {
#pragma unroll
                            for (int j = 0; j < 4; ++j) { v0[j] = fmaxf(sigmoid_f(v0[j]) * 255.f, 1.f); v1[j] = fmaxf(sigmoid_f(v1[j]) * 255.f, 1.f); }
                            u32x2 g8; g8.x = pk4_u8(v0[0], v0[1], v0[2], v0[3]); g8.y = pk4_u8(v1[0], v1[1], v1[2], v1[3]);
                            *(u32x2*)(zm8 + (size_t)(row0 + ai * 128 + m * 16) * LDM8 + (col0 - ZMA) + bj * 32) = g8; continue;
                        }
                        u32x4 w; w.x = cvt_pk_bf16(v0[0], v0[1]); w.y = cvt_pk_bf16(v0[2], v0[3]); w.z = cvt_pk_bf16(v1[0], v1[1]); w.w = cvt_pk_bf16(v1[2], v1[3]);
                        __builtin_nontemporal_store(w, (GAS u32x4*)(rowp + bj * 32));
                    }
                }
        }
    }
};
struct EpiKV {
    static constexpr bool PERM = false, WIDE = false, MID = false, AFTER_DRAIN = false; static constexpr int MID_T1 = -1, MID_T2 = -1;
    __device__ __forceinline__ void pre(f32x4 (&)[2][2][4][2], const Unit&, int, int, int, int, int) const {}
    float* mk; float* mv; bf16_t* kvb;
    __device__ __forceinline__ void mid(f32x4 (&)[2][2][4][2], const Unit&, int, int, int, int, int) const {}
    __device__ __forceinline__ void operator()(const f32x4 (&acc)[2][2][4][2], const Unit& u, int wr, int wc, int fr, int fq) const {
        const int row0 = u.pm * 256 + wr * 64 + fr, col0 = u.pn * 256 + wc * 32 + 4 * fq;
        float* dst = (col0 < 2048) ? mk : mv; const int cc0 = col0 & 2047;
#pragma unroll
        for (int ai = 0; ai < 2; ++ai)
#pragma unroll
            for (int m = 0; m < 4; ++m) { const int row = row0 + ai * 128 + m * 16;
#pragma unroll
                for (int bj = 0; bj < 2; ++bj)
#pragma unroll
                    for (int n = 0; n < 2; ++n) { const f32x4 v = acc[ai][bj][m][n]; const int co = bj * 128 + n * 16;
                        *(f32x4*)(dst + (size_t)row * 2048 + cc0 + co) = v;
                        u32x2 w; w.x = cvt_pk_bf16(v[0], v[1]); w.y = cvt_pk_bf16(v[2], v[3]);
                        *(u32x2*)(kvb + (size_t)row * 4096 + col0 + co) = w; } }
    }
    __device__ __forceinline__ void quarter(const f32x4 (&q)[2][2][2], const Unit& u, int wr, int wc, int fr, int fq, int ai, int mh) const {
        const int row0 = u.pm * 256 + wr * 64 + fr + ai * 128 + mh * 32, col0 = u.pn * 256 + wc * 32 + 4 * fq;
        float* dst = (col0 < 2048) ? mk : mv; const int cc0 = col0 & 2047;
#pragma unroll
        for (int mm = 0; mm < 2; ++mm) { const int row = row0 + mm * 16;
#pragma unroll
            for (int bj = 0; bj < 2; ++bj)
#pragma unroll
                for (int n = 0; n < 2; ++n) { const f32x4 v = q[bj][mm][n]; const int co = bj * 128 + n * 16;
                    *(f32x4*)(dst + (size_t)row * 2048 + cc0 + co) = v;
                    u32x2 w; w.x = cvt_pk_bf16(v[0], v[1]); w.y = cvt_pk_bf16(v[2], v[3]);
                    *(u32x2*)(kvb + (size_t)row * 4096 + col0 + co) = w; } }
    }
};
struct EpiGlu {
    static constexpr bool PERM = true, WIDE = false, MID = false, AFTER_DRAIN = false; static constexpr int MID_T1 = -1, MID_T2 = -1;
    __device__ __forceinline__ void pre(f32x4 (&)[2][2][4][2], const Unit&, int, int, int, int, int) const {}
    const bf16_t* Z; unsigned char* acat;
    __device__ __forceinline__ void mid(f32x4 (&)[2][2][4][2], const Unit&, int, int, int, int, int) const {}
    __device__ __forceinline__ void operator()(const f32x4 (&acc)[2][2][4][2], const Unit& u, int wr, int wc, int fr, int fq) const {
        const int row0 = u.pm * 256 + wr * 64 + fr, col0 = u.pn * 128 + wc * 32 + 8 * fq;
        u32x2 gpre[8];
#pragma unroll
        for (int i = 0; i < 8; ++i) gpre[i] = *(const u32x2*)gate8(Z, (size_t)(row0 + (i >> 2) * 128 + (i & 3) * 16), ZGS, col0);
#pragma unroll
        for (int ai = 0; ai < 2; ++ai)
#pragma unroll
            for (int m = 0; m < 4; ++m) { const int row = row0 + ai * 128 + m * 16;
                float gs8[8]; unpack8_fp8(gpre[ai * 4 + m], gs8);
                float o[8];
#pragma unroll
                for (int n = 0; n < 2; ++n)
#pragma unroll
                    for (int j = 0; j < 4; ++j) o[n * 4 + j] = acc[ai][0][m][n][j] * sigmoid_f(acc[ai][1][m][n][j]) * gs8[n * 4 + j] * (ACS / GSC);
                u32x2 w; w.x = pk4_fp8(o[0], o[1], o[2], o[3]); w.y = pk4_fp8(o[4], o[5], o[6], o[7]);
                *(u32x2*)(acat + (size_t)row * LDA8 + AC_S5 + col0) = w; }
    }
    __device__ __forceinline__ void quarter(const f32x4 (&q)[2][2][2], const Unit& u, int wr, int wc, int fr, int fq, int ai, int mh) const {
        const int row0 = u.pm * 256 + wr * 64 + fr + ai * 128 + mh * 32, col0 = u.pn * 128 + wc * 32 + 8 * fq;
#pragma unroll
        for (int mm = 0; mm < 2; ++mm) { const int row = row0 + mm * 16;
            float gs8[8]; unpack8_fp8(*(const u32x2*)gate8(Z, (size_t)row, ZGS, col0), gs8);
            float o[8];
#pragma unroll
            for (int n = 0; n < 2; ++n)
#pragma unroll
                for (int j = 0; j < 4; ++j) o[n * 4 + j] = q[0][mm][n][j] * sigmoid_f(q[1][mm][n][j]) * gs8[n * 4 + j] * (ACS / GSC);
            u32x2 w; w.x = pk4_fp8(o[0], o[1], o[2], o[3]); w.y = pk4_fp8(o[4], o[5], o[6], o[7]);
            *(u32x2*)(acat + (size_t)row * LDA8 + AC_S5 + col0) = w; }
    }
};
struct EpiProj {
    static constexpr bool PERM = true, WIDE = true, MID = true, AFTER_DRAIN = false; static constexpr int MID_T1 = 32, MID_T2 = 48;
    __device__ __forceinline__ void pre(f32x4 (&)[2][2][4][2], const Unit&, int, int, int, int, int) const {}
    const unsigned char* zm8; unsigned char* merged;
    __device__ __forceinline__ void mid(f32x4 (&acc)[2][2][4][2], const Unit& u, int wr, int wc, int fr, int fq, int which) const {
        const int row0 = u.pm * 256 + wr * 64 + fr, col0 = u.pn * 256 + wc * 64 + 8 * fq;
        const unsigned char* zb = zm8 + (size_t)row0 * LDM8 + col0 + which * 4096;
        u32x2 ga[16], gb[16];
#pragma unroll
        for (int ai = 0; ai < 2; ++ai)
#pragma unroll
            for (int m = 0; m < 4; ++m) { const unsigned char* zr = zb + (size_t)(ai * 128 + m * 16) * LDM8;
#pragma unroll
                for (int bj = 0; bj < 2; ++bj) { ga[(ai * 4 + m) * 2 + bj] = *(const u32x2*)(zr + bj * 32); gb[(ai * 4 + m) * 2 + bj] = *(const u32x2*)(zr + 4096 + bj * 32); } }
#pragma unroll
        for (int ai = 0; ai < 2; ++ai)
#pragma unroll
            for (int m = 0; m < 4; ++m)
#pragma unroll
                for (int bj = 0; bj < 2; ++bj) { const u32x2 a = ga[(ai * 4 + m) * 2 + bj], b = gb[(ai * 4 + m) * 2 + bj];
#pragma unroll
                    for (int n = 0; n < 2; ++n) {
#pragma unroll
                        for (int j = 0; j < 4; ++j) acc[ai][bj][m][n][j] *= ub(a[n], j) * fast_rcp(ub(b[n], j));
                        asm volatile("" : "+v"(acc[ai][bj][m][n])); } }
    }
    __device__ __forceinline__ void operator()(const f32x4 (&acc)[2][2][4][2], const Unit& u, int wr, int wc, int fr, int fq) const {
        const int row0 = u.pm * 256 + wr * 64 + fr, col0 = u.pn * 256 + wc * 64 + 8 * fq;
        u32x2 gc[16];
#pragma unroll
        for (int ai = 0; ai < 2; ++ai)
#pragma unroll
            for (int m = 0; m < 4; ++m) { const unsigned char* zr = zm8 + (size_t)(row0 + ai * 128 + m * 16) * LDM8 + 2 * 4096 + col0;
#pragma unroll
                for (int bj = 0; bj < 2; ++bj) gc[(ai * 4 + m) * 2 + bj] = *(const u32x2*)(zr + bj * 32); }
#pragma unroll
        for (int ai = 0; ai < 2; ++ai)
#pragma unroll
            for (int m = 0; m < 4; ++m) { const int row = row0 + ai * 128 + m * 16;
#pragma unroll
                for (int bj = 0; bj < 2; ++bj) { const u32x2 c = gc[(ai * 4 + m) * 2 + bj]; f32x4 o0, o1;
#pragma unroll
                    for (int j = 0; j < 4; ++j) { o0[j] = acc[ai][bj][m][0][j] * ub(c.x, j); o1[j] = acc[ai][bj][m][1][j] * ub(c.y, j); }
                    *(u32x2*)(merged + (size_t)row * LD8 + col0 + bj * 32) = pk8_fp8(o0, o1, 16.f / 255.f); } }
    }
};
struct EpiOut {
    static constexpr bool PERM = true, WIDE = true, MID = false, AFTER_DRAIN = false; static constexpr int MID_T1 = -1, MID_T2 = -1;
    __device__ __forceinline__ void pre(f32x4 (&)[2][2][4][2], const Unit&, int, int, int, int, int) const {}
    const bf16_t* xbf; bf16_t* vb;
    __device__ __forceinline__ void mid(f32x4 (&)[2][2][4][2], const Unit&, int, int, int, int, int) const {}
    __device__ __forceinline__ void operator()(const f32x4 (&acc)[2][2][4][2], const Unit& u, int wr, int wc, int fr, int fq) const {
        const int row0 = u.pm * 256 + wr * 64 + fr, col0 = u.pn * 256 + wc * 64 + 8 * fq;
        u32x4 xw16[16];
#pragma unroll
        for (int ai = 0; ai < 2; ++ai)
#pragma unroll
            for (int m = 0; m < 4; ++m) { const bf16_t* xr = xbf + (size_t)(row0 + ai * 128 + m * 16) * LDX + col0;
#pragma unroll
                for (int bj = 0; bj < 2; ++bj) xw16[(ai * 4 + m) * 2 + bj] = *(const u32x4*)(xr + bj * 32); }
#pragma unroll
        for (int ai = 0; ai < 2; ++ai)
#pragma unroll
            for (int m = 0; m < 4; ++m) { const int row = row0 + ai * 128 + m * 16;
#pragma unroll
                for (int bj = 0; bj < 2; ++bj) { const u32x4 xw = xw16[(ai * 4 + m) * 2 + bj];
                    const f32x4 x0 = {__uint_as_float(xw.x << 16), __uint_as_float(xw.x & 0xffff0000u), __uint_as_float(xw.y << 16), __uint_as_float(xw.y & 0xffff0000u)}, x1 = {__uint_as_float(xw.z << 16), __uint_as_float(xw.z & 0xffff0000u), __uint_as_float(xw.w << 16), __uint_as_float(xw.w & 0xffff0000u)};
                    const f32x4 v0 = x0 * DN_ALPHA + acc[ai][bj][m][0], v1 = x1 * DN_ALPHA + acc[ai][bj][m][1];
                    u32x4 w; w.x = cvt_pk_bf16(v0[0], v0[1]); w.y = cvt_pk_bf16(v0[2], v0[3]); w.z = cvt_pk_bf16(v1[0], v1[1]); w.w = cvt_pk_bf16(v1[2], v1[3]);
                    *(u32x4*)(vb + (size_t)row * ALD + col0 + bj * 32) = w; } }
    }
    __device__ __forceinline__ void quarter(const f32x4 (&q)[2][2][2], const Unit& u, int wr, int wc, int fr, int fq, int ai, int mh) const {
        const int row0 = u.pm * 256 + wr * 64 + fr + ai * 128 + mh * 32, col0 = u.pn * 256 + wc * 64 + 8 * fq;
#pragma unroll
        for (int mm = 0; mm < 2; ++mm) { const int row = row0 + mm * 16; const bf16_t* xr = xbf + (size_t)row * LDX + col0;
#pragma unroll
            for (int bj = 0; bj < 2; ++bj) { const u32x4 xw = *(const u32x4*)(xr + bj * 32);
                    const f32x4 x0 = {__uint_as_float(xw.x << 16), __uint_as_float(xw.x & 0xffff0000u), __uint_as_float(xw.y << 16), __uint_as_float(xw.y & 0xffff0000u)}, x1 = {__uint_as_float(xw.z << 16), __uint_as_float(xw.z & 0xffff0000u), __uint_as_float(xw.w << 16), __uint_as_float(xw.w & 0xffff0000u)};
                const f32x4 v0 = x0 * DN_ALPHA + q[bj][mm][0], v1 = x1 * DN_ALPHA + q[bj][mm][1];
                u32x4 w; w.x = cvt_pk_bf16(v0[0], v0[1]); w.y = cvt_pk_bf16(v0[2], v0[3]); w.z = cvt_pk_bf16(v1[0], v1[1]); w.w = cvt_pk_bf16(v1[2], v1[3]);
                *(u32x4*)(vb + (size_t)row * ALD + col0 + bj * 32) = w; } }
    }
};
struct EpiProjQ {
    static constexpr bool PERM = true, WIDE = true, MID = false, AFTER_DRAIN = false; static constexpr int MID_T1 = -1, MID_T2 = -1;
    const unsigned char* zm8; unsigned char* merged;
    __device__ __forceinline__ void mid(f32x4 (&)[2][2][4][2], const Unit&, int, int, int, int, int) const {}
    __device__ __forceinline__ void pre(f32x4 (&acc)[2][2][4][2], const Unit& u, int wr, int wc, int fr, int fq, int kq) const {
        const int row0 = u.pm * 256 + wr * 64 + fr, col0 = u.pn * 256 + wc * 64 + 8 * fq;
        const unsigned char* zb = zm8 + (size_t)row0 * LDM8 + col0 + (kq < 2 ? 0 : kq - 1) * 4096;
        u32x2 gpre[16];
#pragma unroll
        for (int i = 0; i < 16; ++i) gpre[i] = *(const u32x2*)(zb + (size_t)((i >> 3) * 128 + ((i >> 1) & 3) * 16) * LDM8 + (i & 1) * 32);
#pragma unroll
        for (int ai = 0; ai < 2; ++ai)
#pragma unroll
            for (int m = 0; m < 4; ++m) {
#pragma unroll
                for (int bj = 0; bj < 2; ++bj) { const u32x2 c = gpre[(ai * 4 + m) * 2 + bj];
#pragma unroll
                    for (int n = 0; n < 2; ++n) {
#pragma unroll
                        for (int j = 0; j < 4; ++j) acc[ai][bj][m][n][j] *= ub(c[n], j) * (1.f / 255.f);
                        asm volatile("" : "+v"(acc[ai][bj][m][n])); } } }
    }
    __device__ __forceinline__ void operator()(const f32x4 (&acc)[2][2][4][2], const Unit& u, int wr, int wc, int fr, int fq) const {
        const int row0 = u.pm * 256 + wr * 64 + fr, col0 = u.pn * 256 + wc * 64 + 8 * fq;
#pragma unroll
        for (int ai = 0; ai < 2; ++ai)
#pragma unroll
            for (int m = 0; m < 4; ++m) { const int row = row0 + ai * 128 + m * 16;
#pragma unroll
                for (int bj = 0; bj < 2; ++bj) *(u32x2*)(merged + (size_t)row * LD8 + col0 + bj * 32) = pk8_fp8(acc[ai][bj][m][0], acc[ai][bj][m][1], 16.f); }
    }
    __device__ __forceinline__ void quarter(const f32x4 (&q)[2][2][2], const Unit& u, int wr, int wc, int fr, int fq, int ai, int mh) const {
        const int row0 = u.pm * 256 + wr * 64 + fr + ai * 128 + mh * 32, col0 = u.pn * 256 + wc * 64 + 8 * fq;
#pragma unroll
        for (int mm = 0; mm < 2; ++mm) { const int row = row0 + mm * 16;
#pragma unroll
            for (int bj = 0; bj < 2; ++bj) *(u32x2*)(merged + (size_t)row * LD8 + col0 + bj * 32) = pk8_fp8(q[bj][mm][0], q[bj][mm][1], 16.f); }
    }
};
constexpr int SLAB_BYTES = 262144;
template <class Inner, int NS = 4> struct EpiSplit {
    static constexpr bool PERM = Inner::PERM, WIDE = Inner::WIDE, MID = false, AFTER_DRAIN = true; static constexpr int MID_T1 = -1, MID_T2 = -1;
    static constexpr bool BF = true; static constexpr int SLB = BF ? SLAB_BYTES / 2 : SLAB_BYTES;
    Inner inner; unsigned char* slab; unsigned* ticket; int kq;
    __device__ __forceinline__ void mid(f32x4 (&)[2][2][4][2], const Unit&, int, int, int, int, int) const {}
    __device__ __forceinline__ void operator()(const f32x4 (&)[2][2][4][2], const Unit&, int, int, int, int) const {}
    __device__ __forceinline__ void fused(f32x4 (&acc)[2][2][4][2], const Unit& u, int wr, int wc, int fr, int fq, LAS unsigned char* lds) const {
        inner.pre(acc, u, wr, wc, fr, fq, kq);
        const __amdgpu_buffer_rsrc_t rs = __builtin_amdgcn_make_buffer_rsrc((void*)slab, (short)0, NS * SLB, 0x00020000);
        const int tid = threadIdx.x; const int off = kq * SLB + tid * 16;
#pragma unroll
        for (int a = 0; a < 2; ++a)
#pragma unroll
            for (int b = 0; b < 2; ++b)
#pragma unroll
                for (int m = 0; m < 4; ++m) {
                    if constexpr (BF) { const f32x4 v0 = acc[a][b][m][0], v1 = acc[a][b][m][1]; u32x4 w; w.x = cvt_pk_bf16(v0[0], v0[1]); w.y = cvt_pk_bf16(v0[2], v0[3]); w.z = cvt_pk_bf16(v1[0], v1[1]); w.w = cvt_pk_bf16(v1[2], v1[3]);
                        __builtin_amdgcn_raw_buffer_store_b128(w, rs, off + ((a * 2 + b) * 4 + m) * 8192, 0, 16); }
                    else {
#pragma unroll
                        for (int n = 0; n < 2; ++n) __builtin_amdgcn_raw_buffer_store_b128(__builtin_bit_cast(u32x4, acc[a][b][m][n]), rs, off + (((a * 2 + b) * 4 + m) * 2 + n) * 8192, 0, 16); } }
        asm volatile("s_waitcnt vmcnt(0)" ::: "memory");
        __syncthreads();
        if (tid == 0) { (void)__hip_atomic_fetch_add(ticket, 1u, __ATOMIC_RELAXED, __HIP_MEMORY_SCOPE_AGENT);
            unsigned sp = 0; while (__hip_atomic_load(ticket, __ATOMIC_RELAXED, __HIP_MEMORY_SCOPE_AGENT) < (unsigned)NS) { __builtin_amdgcn_s_sleep(2); if (++sp > (1u << 22)) break; }
            __builtin_amdgcn_fence(__ATOMIC_ACQUIRE, "wavefront"); }
        __syncthreads();
#pragma unroll 1
        for (int part = 0; part < 4 / NS; ++part) {
            const int ai = (NS == 4) ? (kq >> 1) : kq, mh = (NS == 4) ? (kq & 1) : part;
            f32x4 q[2][2][2];
#pragma unroll
            for (int b = 0; b < 2; ++b)
#pragma unroll
                for (int mm = 0; mm < 2; ++mm)
#pragma unroll
                    for (int n = 0; n < 2; ++n) q[b][mm][n] = (f32x4){0.f, 0.f, 0.f, 0.f};
            if constexpr (BF) {
#pragma unroll
                for (int k = 0; k < NS; ++k) { u32x4 t[4];
#pragma unroll
                    for (int b = 0; b < 2; ++b)
#pragma unroll
                        for (int mm = 0; mm < 2; ++mm) t[b * 2 + mm] = __builtin_amdgcn_raw_buffer_load_b128(rs, k * SLB + tid * 16 + (((ai * 2 + b) * 4 + 2 * mh + mm) * 8192), 0, 16);
#pragma unroll
                    for (int b = 0; b < 2; ++b)
#pragma unroll
                        for (int mm = 0; mm < 2; ++mm) { const u32x4 w = t[b * 2 + mm];
                            q[b][mm][0] += (f32x4){__uint_as_float(w.x << 16), __uint_as_float(w.x & 0xffff0000u), __uint_as_float(w.y << 16), __uint_as_float(w.y & 0xffff0000u)};
                            q[b][mm][1] += (f32x4){__uint_as_float(w.z << 16), __uint_as_float(w.z & 0xffff0000u), __uint_as_float(w.w << 16), __uint_as_float(w.w & 0xffff0000u)}; } }
            } else {
#pragma unroll
                for (int k = 0; k < NS; ++k) { u32x4 t[8];
#pragma unroll
                    for (int b = 0; b < 2; ++b)
#pragma unroll
                        for (int mm = 0; mm < 2; ++mm)
#pragma unroll
                            for (int n = 0; n < 2; ++n) t[(b * 2 + mm) * 2 + n] = __builtin_amdgcn_raw_buffer_load_b128(rs, k * SLB + tid * 16 + ((((ai * 2 + b) * 4 + 2 * mh + mm) * 2 + n) * 8192), 0, 16);
#pragma unroll
                    for (int b = 0; b < 2; ++b)
#pragma unroll
                        for (int mm = 0; mm < 2; ++mm)
#pragma unroll
                            for (int n = 0; n < 2; ++n) q[b][mm][n] += __builtin_bit_cast(f32x4, t[(b * 2 + mm) * 2 + n]); }
            }
            inner.quarter(q, u, wr, wc, fr, fq, ai, mh);
        }
    }
};
struct OneUnit {
    Unit u;
    __device__ __forceinline__ bool next(int i, Unit& o) const { o = u; return i == 0; }
    __device__ __forceinline__ void a_ready(const Unit&) const {}
    __device__ __forceinline__ void done(const Unit&) const {}
};
struct Args { const float* in[25]; float* out; unsigned char* ws; int ph_lo, ph_hi; float lg2g[16]; };
struct Ctx {
    const float* const* in; float* out; unsigned char* ws; const float* lg2g;
    bf16_t *XB, *MEMB, *WIN, *WMKV, *WGLU, *WCAT, *WOUT, *Z, *ACAT, *GL, *MERGED, *KVB; float* ROPE; unsigned char* S5T; unsigned char* A8;
    int tid, lane, wave, G, bid;
};

template <int ROWMAP, bool F8OUT = false>
__device__ __forceinline__ void p0_transpose_item(const float* W, int N, bf16_t* WT, int ldk, int koff, LAS float* scr, int kb, int nb, int lane) {
    const int k0 = 64 * kb, n0 = 32 * nb;
#pragma unroll 8
    for (int i = 0; i < 32; ++i) { const int kk = 2 * i + (lane >> 5); scr[kk * 33 + (lane & 31)] = W[(size_t)(k0 + kk) * N + n0 + (lane & 31)]; }
    asm volatile("s_waitcnt lgkmcnt(0)" ::: "memory");
    const int c = lane & 7;
#pragma unroll
    for (int j = 0; j < 4; ++j) { const int n = (lane >> 3) + 8 * j; const LAS float* s = scr + (8 * c) * 33 + n;
        u32x4 o; o.x = cvt_pk_bf16(s[0 * 33], s[1 * 33]); o.y = cvt_pk_bf16(s[2 * 33], s[3 * 33]); o.z = cvt_pk_bf16(s[4 * 33], s[5 * 33]); o.w = cvt_pk_bf16(s[6 * 33], s[7 * 33]);
        int nn = n0 + n;
        if (ROWMAP == 1) { nn = (nn < 2048) ? (256 * (nn >> 7) + (nn & 127)) : (256 * ((nn - 2048) >> 7) + 128 + (nn & 127)); }
        if constexpr (F8OUT) { const f32x4 lo = {s[0 * 33], s[1 * 33], s[2 * 33], s[3 * 33]}, hi = {s[4 * 33], s[5 * 33], s[6 * 33], s[7 * 33]};
            *(u32x2*)((unsigned char*)WT + (size_t)nn * ldk + koff + k0 + 8 * c) = pk8_fp8(lo, hi, 128.f); }
        else *(u32x4*)(WT + (size_t)nn * ldk + koff + k0 + 8 * c) = o; }
    asm volatile("s_waitcnt lgkmcnt(0)" ::: "memory");
}
__device__ __forceinline__ void p0_win_item(const float* W, bf16_t* WB, unsigned char* W8, LAS float* scr, int kb, int nb, int lane) {
    const int k0 = 64 * kb, n0 = 32 * nb, N = 32768;
#pragma unroll 8
    for (int i = 0; i < 32; ++i) { const int kk = 2 * i + (lane >> 5); scr[kk * 33 + (lane & 31)] = W[(size_t)(k0 + kk) * N + n0 + (lane & 31)]; }
    asm volatile("s_waitcnt lgkmcnt(0)" ::: "memory");
    const int c = lane & 7, tile = n0 >> 8;
    const bool isb = (tile >= 8 && tile < 32) || (tile >= 48 && tile < 56);
    const int ct = isb ? (tile < 32 ? tile - 8 : tile - 24) : (tile < 8 ? tile : (tile < 48 ? tile - 24 : tile - 32));
#pragma unroll
    for (int j = 0; j < 4; ++j) { const int n = (lane >> 3) + 8 * j; const LAS float* sp = scr + (8 * c) * 33 + n; const int row = ct * 256 + ((n0 + n) & 255);
        if (isb) { u32x4 o; o.x = cvt_pk_bf16(sp[0 * 33], sp[1 * 33]); o.y = cvt_pk_bf16(sp[2 * 33], sp[3 * 33]); o.z = cvt_pk_bf16(sp[4 * 33], sp[5 * 33]); o.w = cvt_pk_bf16(sp[6 * 33], sp[7 * 33]);
            *(u32x4*)(WB + (size_t)row * LDX + k0 + 8 * c) = o; }
        else { unsigned w0 = 0u, w1 = 0u;
            w0 = __builtin_amdgcn_cvt_pk_fp8_f32(sp[0 * 33] * 128.f, sp[1 * 33] * 128.f, w0, false); w0 = __builtin_amdgcn_cvt_pk_fp8_f32(sp[2 * 33] * 128.f, sp[3 * 33] * 128.f, w0, true);
            w1 = __builtin_amdgcn_cvt_pk_fp8_f32(sp[4 * 33] * 128.f, sp[5 * 33] * 128.f, w1, false); w1 = __builtin_amdgcn_cvt_pk_fp8_f32(sp[6 * 33] * 128.f, sp[7 * 33] * 128.f, w1, true);
            u32x2 o; o.x = w0; o.y = w1; *(u32x2*)(W8 + (size_t)row * LD8 + k0 + 8 * c) = o; } }
    asm volatile("s_waitcnt lgkmcnt(0)" ::: "memory");
}
__device__ __forceinline__ void cvt_rows_x(const float* src, bf16_t* dst, unsigned char* dst8, size_t n4, size_t gtid, size_t gthreads) {
    for (size_t i = gtid; i < n4; i += gthreads) { const f32x4 v = ((const f32x4*)src)[i]; u32x2 w; w.x = cvt_pk_bf16(v[0], v[1]); w.y = cvt_pk_bf16(v[2], v[3]);
        *(u32x2*)(dst + (i >> 10) * LDX + 4 * (i & 1023)) = w;
        unsigned q = 0u; q = __builtin_amdgcn_cvt_pk_fp8_f32(v[0], v[1], q, false); q = __builtin_amdgcn_cvt_pk_fp8_f32(v[2], v[3], q, true);
        *(unsigned*)(dst8 + (i >> 10) * LD8 + 4 * (i & 1023)) = q; }
}
__device__ __forceinline__ void cvt_rows(const float* src, bf16_t* dst, size_t n4, size_t gtid, size_t gthreads) {
    for (size_t i = gtid; i < n4; i += gthreads) { const f32x4 v = ((const f32x4*)src)[i]; u32x2 w; w.x = cvt_pk_bf16(v[0], v[1]); w.y = cvt_pk_bf16(v[2], v[3]);
        *(u32x2*)(dst + (i >> 10) * LDX + 4 * (i & 1023)) = w; }
}
__device__ __forceinline__ void p0_prologue(const Ctx& C, LAS unsigned char* lds) {
    LAS float* scr = (LAS float*)(lds + C.wave * 16384);
    const int gw = C.bid * 8 + C.wave, NGW = C.G * 8;
    constexpr int I_IN = 64 * 1024, I_MKV = 64 * 128, I_GLU = 32 * 128, I_PA = 64 * 128, I_PB = 32 * 128, I_PC = 32 * 128, I_OUT = 64 * 128;
    constexpr int NITEMS = I_IN + I_MKV + I_GLU + I_PA + I_PB + I_PC + I_OUT;
    for (int it = gw; it < NITEMS; it += NGW) {
        int r = it;
        if (r < I_IN) { p0_win_item(C.in[8], C.WIN, C.ws + WS_WIN8, scr, r / 1024, r % 1024, C.lane); continue; } r -= I_IN;
        if (r < I_MKV) { p0_transpose_item<0>(C.in[9], 4096, C.WMKV, LDX, 0, scr, r / 128, r % 128, C.lane); continue; } r -= I_MKV;
        if (r < I_GLU) { p0_transpose_item<1, true>(C.in[18], 4096, C.WGLU, LDG8, 0, scr, r / 128, r % 128, C.lane); continue; } r -= I_GLU;
        if (r < I_PA) { p0_transpose_item<0, true>(C.in[19], 4096, C.WCAT, LDA8, 0, scr, r / 128, r % 128, C.lane); continue; } r -= I_PA;
        if (r < I_PB) { p0_transpose_item<0, true>(C.in[20], 4096, C.WCAT, LDA8, 4096, scr, r / 128, r % 128, C.lane); continue; } r -= I_PB;
        if (r < I_PC) { p0_transpose_item<0, true>(C.in[21], 4096, C.WCAT, LDA8, 6144, scr, r / 128, r % 128, C.lane); continue; } r -= I_PC;
        p0_transpose_item<0, true>(C.in[22], 4096, C.WOUT, LD8, 0, scr, r / 128, r % 128, C.lane);
    }
    const size_t gtid = (size_t)C.bid * 512 + C.tid, gth = (size_t)C.G * 512;
    cvt_rows_x(C.in[0], C.XB, C.ws + WS_XB8, (size_t)TP * DM / 4, gtid, gth);
    cvt_rows_x(C.in[1], C.XB + (size_t)TP * LDX, C.ws + WS_XB8 + (size_t)TP * LD8, (size_t)TS * DM / 4, gtid, gth);
    cvt_rows(C.in[2], C.MEMB, (size_t)1024 * DM / 4, gtid, gth);
    for (size_t e = gtid; e < (size_t)2056 * 64; e += gth) {
        const int prow = (int)(e >> 6), ip = (int)(e & 63); const int pos = prow < 2048 ? prow : 16384 + (prow - 2048);
        const float inv = exp2f(-(float)ip * (13.287712379549449f / 64.f)); const float ang = (float)pos * inv;
        ((unsigned*)C.ROPE)[e] = cvt_pk_bf16(cosf(ang), sinf(ang));
    }
    float* ABAR = (float*)(C.S5T + S5_ABAR); bf16_t* BFR = (bf16_t*)(C.S5T + S5_BFRAG); bf16_t* CFR = (bf16_t*)(C.S5T + S5_CFRAG);
    if (C.tid < 32) {
        const size_t e = (size_t)C.tid * 256 + (size_t)(C.bid & 255);
        const int gi = (int)(e >> 6), n = (int)(e & 63);
        const double dt = exp((double)C.in[12][gi]), ar = (double)C.in[10][e], ai = (double)C.in[11][e];
        const double mag = exp(dt * ar), abr = mag * cos(dt * ai), abi = mag * sin(dt * ai), den = ar * ar + ai * ai, xr = abr - 1.0;
        const double fre = (xr * ar + abi * ai) / den, fim = (abi * ar - xr * ai) / den;
        ABAR[2 * e] = (float)abr; ABAR[2 * e + 1] = (float)abi;
        const float* br = C.in[13] + e * 16; const float* bi = C.in[14] + e * 16;
        const int r = n & 31;
#pragma unroll
        for (int comp = 0; comp < 2; ++comp) { const int c = (n >> 5) + 2 * comp;
#pragma unroll
            for (int hh = 0; hh < 2; ++hh) { float v[8];
#pragma unroll
                for (int j = 0; j < 8; ++j) { const int p = 8 * hh + j; const double b_r = br[p], b_i = bi[p]; v[j] = (float)(comp ? (fre * b_i + fim * b_r) : (fre * b_r - fim * b_i)); }
                u32x4 w; w.x = cvt_pk_bf16(v[0], v[1]); w.y = cvt_pk_bf16(v[2], v[3]); w.z = cvt_pk_bf16(v[4], v[5]); w.w = cvt_pk_bf16(v[6], v[7]);
                *(u32x4*)(BFR + (((size_t)gi * 4 + c) * 64 + r + 32 * hh) * 8) = w; } }
    }
    for (size_t e = gtid; e < (size_t)128 * 5 * 64; e += gth) {
        const int l = (int)(e & 63), ks = (int)((e >> 6) % 5), gi = (int)(e / 320); const int p = l & 15, gq = l >> 4; float v[8];
#pragma unroll
        for (int j = 0; j < 8; ++j) { const int k = 32 * ks + 8 * gq + j;
            if (k < 128) { const int n = ((k >> 1) & 31) + 32 * (k >> 6), comp = k & 1; const size_t ci = ((size_t)gi * 16 + p) * 64 + n; v[j] = comp ? -C.in[16][ci] : C.in[15][ci]; }
            else v[j] = (k - 128 == p) ? C.in[17][gi * 16 + p] : 0.f; }
        u32x4 w; w.x = cvt_pk_bf16(v[0], v[1]); w.y = cvt_pk_bf16(v[2], v[3]); w.z = cvt_pk_bf16(v[4], v[5]); w.w = cvt_pk_bf16(v[6], v[7]);
        *(u32x4*)(CFR + e * 8) = w;
    }
}

template <int O0, int O1, int O2, int O3>
__device__ __forceinline__ void tr_frag2(unsigned addr, bf16x8& f0, bf16x8& f1) {
    u32x2 a, b, c, d;
    asm volatile("ds_read_b64_tr_b16 %0, %4 offset:%5\n\tds_read_b64_tr_b16 %1, %4 offset:%6\n\tds_read_b64_tr_b16 %2, %4 offset:%7\n\tds_read_b64_tr_b16 %3, %4 offset:%8\n\ts_waitcnt lgkmcnt(0)"
                 : "=&v"(a), "=&v"(b), "=&v"(c), "=&v"(d) : "v"(addr), "i"(O0), "i"(O1), "i"(O2), "i"(O3) : "memory");
    u32x4 x; x.x = a.x; x.y = a.y; x.z = b.x; x.w = b.y; f0 = __builtin_bit_cast(bf16x8, x);
    u32x4 y; y.x = c.x; y.y = c.y; y.z = d.x; y.w = d.y; f1 = __builtin_bit_cast(bf16x8, y);
}
__device__ __forceinline__ void ret_prompt_unit(const Ctx& C, LAS unsigned char* lds, int b, int h) {
    const int tid = C.tid, lane = C.lane, w = C.wave, fr = lane & 15, gq = lane >> 4;
    constexpr int QP = 272, VP = 528, PP = 144;
    LAS unsigned char* Qs = lds; LAS unsigned char* Ks = lds + 17408; LAS unsigned char* Vs = lds + 34816; LAS unsigned char* Ps = lds + 68608;
    LAS float* RED = (LAS float*)(lds + 77824);
    const bf16_t* Z = C.Z;
    f32x4 S[8][2];
#pragma unroll
    for (int i = 0; i < 8; ++i) { S[i][0] = (f32x4){0.f, 0.f, 0.f, 0.f}; S[i][1] = (f32x4){0.f, 0.f, 0.f, 0.f}; }
    const float g64 = exp2f(C.lg2g[h] * 64.f);
    const int qrow = tid >> 4, qc = tid & 15, vrow = tid >> 5, vc = tid & 31;
    const bf16_t* zq = Z + ((size_t)b * 2048 + qrow) * ZLD + ZQ + h * 128 + 8 * qc;
    const bf16_t* zv = Z + ((size_t)b * 2048 + vrow) * ZLD + ZV + h * 256 + 8 * vc;
    u32x4 rq[2], rk[2], rv[4]; u32x2 rg[4];
    const unsigned char* zg = gate8(Z, (size_t)b * 2048 + vrow, ZGR, h * 256 + 8 * vc);
#pragma unroll
    for (int s = 0; s < 2; ++s) { rq[s] = *(const u32x4*)(zq + (size_t)(32 * s) * ZLD); rk[s] = *(const u32x4*)(zq + (size_t)(32 * s) * ZLD + (ZK - ZQ)); }
#pragma unroll
    for (int s = 0; s < 4; ++s) { rv[s] = *(const u32x4*)(zv + (size_t)(16 * s) * ZLD); rg[s] = *(const u32x2*)(zg + (size_t)(16 * s) * (ZLD * 2)); }
    const unsigned trv = (unsigned)(size_t)(Vs + VP * (8 * gq + (fr >> 2)) + 8 * (fr & 3) + 64 * w);
    const unsigned trk = (unsigned)(size_t)(Ks + QP * (8 * gq + (fr >> 2)) + 8 * (fr & 3));
    u32x2 wvp[4];
#pragma unroll 1
    for (int c = 0; c < 32; ++c) {
        const size_t t0 = (size_t)b * 2048 + 64 * c;
        __syncthreads();
#pragma unroll
        for (int s = 0; s < 2; ++s) { *(LAS u32x4*)(Qs + (qrow + 32 * s) * QP + 16 * qc) = rq[s]; *(LAS u32x4*)(Ks + (qrow + 32 * s) * QP + 16 * qc) = rk[s]; }
#pragma unroll
        for (int s = 0; s < 4; ++s) *(LAS u32x4*)(Vs + (vrow + 16 * s) * VP + 16 * vc) = rv[s];
        u32x2 gcur[4];
#pragma unroll
        for (int s = 0; s < 4; ++s) gcur[s] = rg[s];
        if (tid < 128) RED[tid] = 0.f;
        if (c > 0) {
#pragma unroll
            for (int s = 0; s < 4; ++s) *(u32x2*)(C.A8 + (t0 - 64 + vrow + 16 * s) * LDA8 + AC_RET + h * 256 + 8 * vc) = wvp[s]; }
        if (c < 31) {
            const size_t adv = (size_t)(64 * (c + 1)) * ZLD;
#pragma unroll
            for (int s = 0; s < 2; ++s) { rq[s] = *(const u32x4*)(zq + adv + (size_t)(32 * s) * ZLD); rk[s] = *(const u32x4*)(zq + adv + (size_t)(32 * s) * ZLD + (ZK - ZQ)); }
#pragma unroll
            for (int s = 0; s < 4; ++s) { rv[s] = *(const u32x4*)(zv + adv + (size_t)(16 * s) * ZLD); rg[s] = *(const u32x2*)(zg + (adv + (size_t)(16 * s) * ZLD) * 2); }
        }
        __syncthreads();
        { const int ti = w >> 1;
#pragma unroll
          for (int q2 = 0; q2 < 2; ++q2) { const int tj = 2 * (w & 1) + q2; f32x4 pa = (f32x4){0.f, 0.f, 0.f, 0.f};
            if (tj <= ti) {
#pragma unroll
                for (int ks = 0; ks < 4; ++ks) { const bf16x8 a = *(const LAS bf16x8*)(Qs + (16 * ti + fr) * QP + (32 * ks + 8 * gq) * 2); const bf16x8 bb = *(const LAS bf16x8*)(Ks + (16 * tj + fr) * QP + (32 * ks + 8 * gq) * 2); pa = mfma16(a, bb, pa); } }
#pragma unroll
            for (int r = 0; r < 4; ++r) { const int i = 16 * ti + 4 * gq + r, j = 16 * tj + fr; const float v = (tj <= ti && i >= j) ? pa[r] : 0.f; *(LAS unsigned short*)(Ps + i * PP + 2 * j) = f2bf(v); } } }
        __builtin_amdgcn_sched_barrier(0);
        f32x4 o[4][2];
#pragma unroll
        for (int mt = 0; mt < 4; ++mt) { o[mt][0] = (f32x4){0.f, 0.f, 0.f, 0.f}; o[mt][1] = (f32x4){0.f, 0.f, 0.f, 0.f}; }
#pragma unroll
        for (int ks = 0; ks < 4; ++ks) {
            bf16x8 bfr[2];
#pragma unroll
            for (int nt = 0; nt < 2; ++nt) { u32x4 wv; wv.x = cvt_pk_bf16(S[2 * ks][nt][0], S[2 * ks][nt][1]); wv.y = cvt_pk_bf16(S[2 * ks][nt][2], S[2 * ks][nt][3]);
                wv.z = cvt_pk_bf16(S[2 * ks + 1][nt][0], S[2 * ks + 1][nt][1]); wv.w = cvt_pk_bf16(S[2 * ks + 1][nt][2], S[2 * ks + 1][nt][3]); bfr[nt] = __builtin_bit_cast(bf16x8, wv); }
#pragma unroll
            for (int mt = 0; mt < 4; ++mt) { const u32x2 lo = *(const LAS u32x2*)(Qs + (16 * mt + fr) * QP + (32 * ks + 4 * gq) * 2), hi = *(const LAS u32x2*)(Qs + (16 * mt + fr) * QP + (32 * ks + 16 + 4 * gq) * 2);
                u32x4 av; av.x = lo.x; av.y = lo.y; av.z = hi.x; av.w = hi.y; const bf16x8 a = __builtin_bit_cast(bf16x8, av);
                o[mt][0] = mfma16(a, bfr[0], o[mt][0]); o[mt][1] = mfma16(a, bfr[1], o[mt][1]); }
            __builtin_amdgcn_sched_barrier(0);
        }
        __syncthreads();
        bf16x8 vfr[2][2];
        tr_frag2<0, 4 * VP, 32 * VP, 36 * VP>(trv, vfr[0][0], vfr[0][1]);
        tr_frag2<32, 32 + 4 * VP, 32 + 32 * VP, 32 + 36 * VP>(trv, vfr[1][0], vfr[1][1]);
#pragma unroll
        for (int mt = 0; mt < 4; ++mt)
#pragma unroll
            for (int ks = 0; ks < 2; ++ks) if (ks == 0 || mt >= 2) { const bf16x8 a = *(const LAS bf16x8*)(Ps + (16 * mt + fr) * PP + (32 * ks + 8 * gq) * 2);
                o[mt][0] = mfma16(a, vfr[0][ks], o[mt][0]); o[mt][1] = mfma16(a, vfr[1][ks], o[mt][1]); }
#define RP_SUPD(md) do { bf16x8 ka0, ka1; tr_frag2<32 * (md), 32 * (md) + 4 * QP, 32 * (md) + 32 * QP, 32 * (md) + 36 * QP>(trk, ka0, ka1); \
            S[md][0] = mfma16(ka0, vfr[0][0], S[md][0]); S[md][1] = mfma16(ka0, vfr[1][0], S[md][1]); S[md][0] = mfma16(ka1, vfr[0][1], S[md][0]); S[md][1] = mfma16(ka1, vfr[1][1], S[md][1]); \
            S[md][0] = S[md][0] * g64; S[md][1] = S[md][1] * g64; } while (0)
        RP_SUPD(0); RP_SUPD(1); RP_SUPD(2); RP_SUPD(3); RP_SUPD(4); RP_SUPD(5); RP_SUPD(6); RP_SUPD(7);
#undef RP_SUPD
#pragma unroll
        for (int mt = 0; mt < 4; ++mt) { float s1v[4], s2v[4];
#pragma unroll
            for (int r = 0; r < 4; ++r) { s1v[r] = row16_sum(o[mt][0][r] + o[mt][1][r]); s2v[r] = row16_sum(o[mt][0][r] * o[mt][0][r] + o[mt][1][r] * o[mt][1][r]); }
            if (fr == 0) {
#pragma unroll
                for (int r = 0; r < 4; ++r) { const int i = 16 * mt + 4 * gq + r; __hip_atomic_fetch_add(RED + 2 * i, s1v[r], __ATOMIC_RELAXED, __HIP_MEMORY_SCOPE_WORKGROUP); __hip_atomic_fetch_add(RED + 2 * i + 1, s2v[r], __ATOMIC_RELAXED, __HIP_MEMORY_SCOPE_WORKGROUP); } } }
        __syncthreads();
        LAS unsigned char* obw = opq(Qs + (4 * gq) * 528 + (32 * w + fr) * 2);
#pragma unroll
        for (int mt = 0; mt < 4; ++mt)
#pragma unroll
            for (int r = 0; r < 4; ++r) { const int i = 16 * mt + 4 * gq + r; const float mean = RED[2 * i] * (1.f / 256.f); const float var = fmaxf(RED[2 * i + 1] * (1.f / 256.f) - mean * mean, 0.f); const float rstd = rsqrtf(var + 1e-5f);
#pragma unroll
                for (int nt = 0; nt < 2; ++nt) *(LAS unsigned short*)(obw + (16 * mt + r) * 528 + 32 * nt) = f2bf((o[mt][nt][r] - mean) * rstd); }
        __syncthreads();
#pragma unroll
        for (int s = 0; s < 4; ++s) { const int row = vrow + 16 * s;
            const u32x4 ov = *(const LAS u32x4*)(Qs + row * 528 + 16 * vc);
            float gv[8]; unpack8_fp8(gcur[s], gv);
            float pv[8];
#pragma unroll
            for (int q = 0; q < 4; ++q) { pv[2 * q] = __uint_as_float(ov[q] << 16) * gv[2 * q] * (ACS / GSC); pv[2 * q + 1] = __uint_as_float(ov[q] & 0xffff0000u) * gv[2 * q + 1] * (ACS / GSC); }
            wvp[s].x = pk4_fp8(pv[0], pv[1], pv[2], pv[3]); wvp[s].y = pk4_fp8(pv[4], pv[5], pv[6], pv[7]); }
    }
#pragma unroll
    for (int s = 0; s < 4; ++s) *(u32x2*)(C.A8 + ((size_t)b * 2048 + 64 * 31 + vrow + 16 * s) * LDA8 + AC_RET + h * 256 + 8 * vc) = wvp[s];
    GAS float* so = opqg(C.out + O_RETP + ((size_t)(b * 16 + h) * 128 + 4 * gq) * 256 + 32 * w + fr);
#pragma unroll
    for (int md = 0; md < 8; ++md) { GAS float* sp = opqg((float*)(so + (size_t)(16 * md) * 256));
#pragma unroll
        for (int nt = 0; nt < 2; ++nt)
#pragma unroll
            for (int r = 0; r < 4; ++r) sp[r * 256 + 16 * nt] = S[md][nt][r]; }
}

__device__ __forceinline__ void rs_request(const Ctx& C, int id, unsigned short (&qkv)[8], unsigned& gw, f32x4 (&st)[16]) {
    const int tid = C.tid, lane = C.lane, w = C.wave, b = id >> 4, h = id & 15, e4 = 4 * lane;
    const bf16_t* Z = C.Z; const size_t t0 = (size_t)TP + (size_t)b * 8;
    const bf16_t* zr = Z + t0 * ZLD + ((tid < 128) ? (ZQ + h * 128 + tid) : (tid < 256) ? (ZK + h * 128 + tid - 128) : (ZV + h * 256 + tid - 256));
#pragma unroll
    for (int i = 0; i < 8; ++i) qkv[i] = zr[(size_t)i * ZLD];
    gw = *(const unsigned*)gate8(Z, t0 + w, ZGR, h * 256 + e4);
    const float* sin_ = C.in[3] + ((size_t)(b * 16 + h) * 128 + 16 * w) * 256 + e4;
#pragma unroll
    for (int dd = 0; dd < 16; ++dd) st[dd] = *(const f32x4*)(sin_ + (size_t)dd * 256);
}
__device__ __forceinline__ void ret_sample_stream(const Ctx& C, LAS unsigned char* lds, unsigned* queue, volatile LAS unsigned* slot, int nunits) {
    const int tid = C.tid, lane = C.lane, w = C.wave, e4 = 4 * lane;
    LAS float* qT = (LAS float*)lds;
    LAS float* kT = (LAS float*)(lds + 4096);
    LAS float* vS = (LAS float*)(lds + 8192);
    LAS float* pS = (LAS float*)(lds + 16384);
    LAS float* red = (LAS float*)(lds + 16640);
    int id;
    __syncthreads();
    if (tid == 0) *slot = __hip_atomic_fetch_add(queue, 1u, __ATOMIC_RELAXED, __HIP_MEMORY_SCOPE_AGENT);
    __syncthreads();
    id = (int)__builtin_amdgcn_readfirstlane(*slot);
    if (id >= nunits) return;
    unsigned short qkv[8]; unsigned gw; f32x4 st[16];
    rs_request(C, id % 2048, qkv, gw, st);
#pragma unroll 1
    for (;;) {
        const int uid = id % 2048, b = uid >> 4, h = uid & 15; const size_t t0 = (size_t)TP + (size_t)b * 8;
        unsigned nid_r = 0u;
        if (tid == 0) nid_r = __hip_atomic_fetch_add(queue, 1u, __ATOMIC_RELAXED, __HIP_MEMORY_SCOPE_AGENT);
        __syncthreads();
        if (tid < 256) { LAS float* dst = (tid < 128) ? (qT + tid * 8) : (kT + (tid - 128) * 8);
#pragma unroll
            for (int i = 0; i < 8; ++i) dst[i] = bf2f(qkv[i]);
        } else { const int e = tid - 256;
#pragma unroll
            for (int i = 0; i < 8; ++i) vS[i * 256 + e] = bf2f(qkv[i]);
        }
        __syncthreads();
        { const int pr = tid >> 3, i = pr >> 3, j = pr & 7, d0 = 16 * (tid & 7); float sacc = 0.f;
#pragma unroll
          for (int d = 0; d < 16; ++d) sacc += qT[(d0 + d) * 8 + i] * kT[(d0 + d) * 8 + j];
          sacc += dpp_mov<0xB1>(sacc); sacc += dpp_mov<0x4E>(sacc); sacc += dpp_mov<0x141>(sacc);
          if ((tid & 7) == 0) pS[pr] = (j <= i) ? sacc : 0.f; }
        const float g8 = exp2f(C.lg2g[h] * 8.f);
        f32x4 v4[8], o[8];
#pragma unroll
        for (int j = 0; j < 8; ++j) { v4[j] = *(const LAS f32x4*)(vS + j * 256 + e4); o[j] = (f32x4){0.f, 0.f, 0.f, 0.f}; }
        float* sout = C.out + O_RETS + ((size_t)(b * 16 + h) * 128 + 16 * w) * 256 + e4;
#pragma unroll
        for (int dd = 0; dd < 16; ++dd) { const int d = 16 * w + dd;
            const f32x4 q0 = *(const LAS f32x4*)(qT + d * 8), q1 = *(const LAS f32x4*)(qT + d * 8 + 4), k0 = *(const LAS f32x4*)(kT + d * 8), k1 = *(const LAS f32x4*)(kT + d * 8 + 4);
            const f32x4 sv = st[dd]; f32x4 sn = sv;
#pragma unroll
            for (int i = 0; i < 4; ++i) { o[i] += sv * q0[i]; o[4 + i] += sv * q1[i]; sn += v4[i] * k0[i]; sn += v4[4 + i] * k1[i]; }
            *(f32x4*)(sout + (size_t)dd * 256) = sn * g8; }
#pragma unroll
        for (int i = 0; i < 8; ++i) *(LAS f32x4*)(red + (w * 8 + i) * 256 + e4) = o[i];
        if (tid == 0) *slot = nid_r;
        __syncthreads();
        const int nid = (int)__builtin_amdgcn_readfirstlane(*slot);
        const unsigned gcur = gw;
        if (nid < nunits) rs_request(C, nid % 2048, qkv, gw, st);
        { const int i = w; f32x4 a = (f32x4){0.f, 0.f, 0.f, 0.f};
#pragma unroll
          for (int ww = 0; ww < 8; ++ww) a += *(const LAS f32x4*)(red + (ww * 8 + i) * 256 + e4);
#pragma unroll
          for (int j = 0; j < 8; ++j) a += *(const LAS f32x4*)(vS + j * 256 + e4) * pS[i * 8 + j];
          const float mean = wave_sum((a[0] + a[1]) + (a[2] + a[3])) * (1.f / 256.f);
          const f32x4 dv = a - mean; const float var = wave_sum((dv[0] * dv[0] + dv[1] * dv[1]) + (dv[2] * dv[2] + dv[3] * dv[3])) * (1.f / 256.f);
          const float rstd = rsqrtf(var + 1e-5f);
          float g4[4]; unpack4_fp8(gcur, g4); const float g0 = g4[0], g1 = g4[1], g2 = g4[2], g3 = g4[3];
          const float rs8 = rstd * (ACS / GSC);
          *(unsigned*)(C.A8 + (t0 + i) * LDA8 + AC_RET + h * 256 + e4) = pk4_fp8(dv[0] * rs8 * g0, dv[1] * rs8 * g1, dv[2] * rs8 * g2, dv[3] * rs8 * g3); }
        if (nid >= nunits) break;
        id = nid;
    }
}

struct S5Tab { bf16x8 bf[4]; bf16x8 cf[5]; float ar0, ai0, ar1, ai1; };
constexpr int S5_WB = 12288, YWP = 48;
constexpr int HTP = 336;
__device__ __forceinline__ void s5_load_tab(const Ctx& C, int gi, int lane, S5Tab& T) {
    const bf16_t* BFR = (const bf16_t*)(C.S5T + S5_BFRAG); const bf16_t* CFR = (const bf16_t*)(C.S5T + S5_CFRAG); const float* ABAR = (const float*)(C.S5T + S5_ABAR);
#pragma unroll
    for (int c = 0; c < 4; ++c) T.bf[c] = *(const bf16x8*)(BFR + (((size_t)gi * 4 + c) * 64 + lane) * 8);
#pragma unroll
    for (int c = 0; c < 5; ++c) T.cf[c] = *(const bf16x8*)(CFR + (((size_t)gi * 5 + c) * 64 + lane) * 8);
    const int r = lane & 31; T.ar0 = ABAR[((size_t)gi * 64 + r) * 2]; T.ai0 = ABAR[((size_t)gi * 64 + r) * 2 + 1]; T.ar1 = ABAR[((size_t)gi * 64 + 32 + r) * 2]; T.ai1 = ABAR[((size_t)gi * 64 + 32 + r) * 2 + 1];
}
#define S5_BU(afrag) \
    f32x16 bre0 = __builtin_amdgcn_mfma_f32_32x32x16_bf16(afrag, T.bf[0], zero16, 0, 0, 0), bre1 = __builtin_amdgcn_mfma_f32_32x32x16_bf16(afrag, T.bf[1], zero16, 0, 0, 0), \
           bim0 = __builtin_amdgcn_mfma_f32_32x32x16_bf16(afrag, T.bf[2], zero16, 0, 0, 0), bim1 = __builtin_amdgcn_mfma_f32_32x32x16_bf16(afrag, T.bf[3], zero16, 0, 0, 0); \
      \
    __builtin_amdgcn_sched_barrier(0); asm volatile("s_nop 15\n\ts_nop 15" : "+v"(bre0), "+v"(bre1), "+v"(bim0), "+v"(bim1)); __builtin_amdgcn_sched_barrier(0)
#define S5_STEP(t) do { const float nr0 = __builtin_fmaf(T.ar0, hr0, __builtin_fmaf(-T.ai0, hi0, bre0[t])), ni0 = __builtin_fmaf(T.ar0, hi0, __builtin_fmaf(T.ai0, hr0, bim0[t])); hr0 = nr0; hi0 = ni0; \
                        const float nr1 = __builtin_fmaf(T.ar1, hr1, __builtin_fmaf(-T.ai1, hi1, bre1[t])), ni1 = __builtin_fmaf(T.ar1, hi1, __builtin_fmaf(T.ai1, hr1, bim1[t])); hr1 = nr1; hi1 = ni1; } while (0)
#define S5_PUT(t) do { *(LAS unsigned*)(Ht + (16 * H + (t)) * HTP + 4 * r) = cvt_pk_bf16(hr0, hi0); *(LAS unsigned*)(Ht + (16 * H + (t)) * HTP + 128 + 4 * r) = cvt_pk_bf16(hr1, hi1); } while (0)
__device__ __forceinline__ void s5_y(const S5Tab& T, const LAS unsigned char* Ht, int lane, f32x4 (&yv)[2]) {
    const int fr = lane & 15, gq = lane >> 4;
#pragma unroll
    for (int mt = 0; mt < 2; ++mt) { yv[mt] = (f32x4){0.f, 0.f, 0.f, 0.f};
#pragma unroll
        for (int ks = 0; ks < 5; ++ks) { const bf16x8 a = *(const LAS bf16x8*)(Ht + (16 * mt + fr) * HTP + (32 * ks + 8 * gq) * 2); yv[mt] = mfma16(a, T.cf[ks], yv[mt]); } }
}
__device__ __forceinline__ void s5_prompt_unit(const Ctx& C, LAS unsigned char* lds, int b, int gi) {
    const int lane = C.lane, w = C.wave, r = lane & 31, H = lane >> 5, fr = lane & 15, gq = lane >> 4;
    LAS unsigned char* Ht = lds + w * S5_WB; LAS unsigned char* Yw = Ht + 32 * HTP; LAS float* Es = (LAS float*)(lds + 8 * S5_WB);
    const bf16_t* Z = C.Z;
    S5Tab T; s5_load_tab(C, gi, lane, T);
    const f32x16 zero16 = {0.f, 0.f, 0.f, 0.f, 0.f, 0.f, 0.f, 0.f, 0.f, 0.f, 0.f, 0.f, 0.f, 0.f, 0.f, 0.f};
    const size_t tb = (size_t)b * 2048 + 256 * w;
    const int Hc = (r >> 2) & 1, reg = (r & 3) + 4 * (r >> 3);
    const bf16_t* up = Z + (tb + 128 * Hc + reg) * ZLD + ZU + gi * 16 + 8 * H;
    LAS unsigned char* uw = Ht + (16 * Hc + reg) * HTP + 256 + 16 * H;
    __syncthreads();
    if (lane < 32) *(LAS u32x4*)(Ht + lane * HTP + 288) = (u32x4){0u, 0u, 0u, 0u};
    if (lane < 32) *(LAS u32x4*)(Ht + lane * HTP + 304) = (u32x4){0u, 0u, 0u, 0u};
    float hr0 = 0.f, hi0 = 0.f, hr1 = 0.f, hi1 = 0.f;
    bf16x8 af[8];
#pragma unroll
    for (int s = 0; s < 8; ++s) af[s] = *(const bf16x8*)(up + (size_t)(16 * s) * ZLD);
#pragma unroll
    for (int s = 0; s < 8; ++s) { S5_BU(af[s]);
#pragma unroll
        for (int t = 0; t < 16; ++t) S5_STEP(t); }
    { const int sc = 2 * w + H; Es[(sc * 4 + 0) * 32 + r] = hr0; Es[(sc * 4 + 1) * 32 + r] = hi0; Es[(sc * 4 + 2) * 32 + r] = hr1; Es[(sc * 4 + 3) * 32 + r] = hi1; }
    __syncthreads();
    {
        float pr0 = T.ar0, pi0 = T.ai0, pr1 = T.ar1, pi1 = T.ai1;
#pragma unroll
        for (int q = 0; q < 7; ++q) { const float a = pr0 * pr0 - pi0 * pi0, bq = 2.f * pr0 * pi0; pr0 = a; pi0 = bq; const float c = pr1 * pr1 - pi1 * pi1, d = 2.f * pr1 * pi1; pr1 = c; pi1 = d; }
        const int sc = 2 * w + H; hr0 = 0.f; hi0 = 0.f; hr1 = 0.f; hi1 = 0.f;
#pragma unroll 1
        for (int s2 = 0; s2 < 15; ++s2) { if (s2 < sc) { const float e0 = Es[(s2 * 4 + 0) * 32 + r], e1 = Es[(s2 * 4 + 1) * 32 + r], e2 = Es[(s2 * 4 + 2) * 32 + r], e3 = Es[(s2 * 4 + 3) * 32 + r];
                const float nr0 = pr0 * hr0 - pi0 * hi0 + e0, ni0 = pr0 * hi0 + pi0 * hr0 + e1; hr0 = nr0; hi0 = ni0;
                const float nr1 = pr1 * hr1 - pi1 * hi1 + e2, ni1 = pr1 * hi1 + pi1 * hr1 + e3; hr1 = nr1; hi1 = ni1; } }
    }
    {
      unsigned char* glp = (unsigned char*)C.GL + (tb + 128 * (lane >> 5) + ((lane >> 1) & 15)) * LDG8 + gi * 16 + 8 * (lane & 1);
#pragma unroll
      for (int s = 0; s < 8; ++s) {
        S5_BU(af[s]);
        *(LAS bf16x8*)uw = af[s];
#pragma unroll
        for (int t = 0; t < 16; ++t) { S5_STEP(t); S5_PUT(t); }
        asm volatile("s_waitcnt lgkmcnt(0)" ::: "memory");
        f32x4 yv[2]; s5_y(T, Ht, lane, yv);
#pragma unroll
        for (int mt = 0; mt < 2; ++mt)
#pragma unroll
            for (int q = 0; q < 4; ++q) *(LAS unsigned short*)(Yw + (16 * mt + 4 * gq + q) * YWP + 2 * fr) = f2bf(gelu_tanh_f(yv[mt][q]));
        asm volatile("s_waitcnt lgkmcnt(0)" ::: "memory");
        *(u32x2*)(glp + (size_t)(16 * s) * LDG8) = bf8_to_fp8(*(const LAS u32x4*)(Yw + (lane >> 1) * YWP + 16 * (lane & 1)), ACS);
        asm volatile("s_waitcnt lgkmcnt(0)" ::: "memory"); } }
    if (w == 7 && H == 1) { const size_t o = ((size_t)b * 128 + gi) * 64; C.out[O_S5RP + o + r] = hr0; C.out[O_S5IP + o + r] = hi0; C.out[O_S5RP + o + 32 + r] = hr1; C.out[O_S5IP + o + 32 + r] = hi1; }
}
__device__ __forceinline__ void s5_sample_unit(const Ctx& C, LAS unsigned char* lds, int gi, int bq) {
    const int lane = C.lane, w = C.wave, r = lane & 31, H = lane >> 5, fr = lane & 15, gq = lane >> 4;
    LAS unsigned char* Ht = lds + w * S5_WB; LAS unsigned char* Yw = Ht + 32 * HTP;
    const bf16_t* Z = C.Z;
    S5Tab T; s5_load_tab(C, gi, lane, T);
    const f32x16 zero16 = {0.f, 0.f, 0.f, 0.f, 0.f, 0.f, 0.f, 0.f, 0.f, 0.f, 0.f, 0.f, 0.f, 0.f, 0.f, 0.f};
    const int bbase = 32 * bq + 4 * w;
    const int Hc = (r >> 2) & 1, reg = (r & 3) + 4 * (r >> 3);
    const bf16x8 af = *(const bf16x8*)(Z + ((size_t)TP + (size_t)(bbase + 2 * Hc + (reg >> 3)) * 8 + (reg & 7)) * ZLD + ZU + gi * 16 + 8 * H);
    const float* sre = C.in[4]; const float* sim = C.in[5];
    float h0v[2][4];
#pragma unroll
    for (int q = 0; q < 2; ++q) { const size_t so = ((size_t)(bbase + 2 * H + q) * 128 + gi) * 64; h0v[q][0] = sre[so + r]; h0v[q][1] = sim[so + r]; h0v[q][2] = sre[so + 32 + r]; h0v[q][3] = sim[so + 32 + r]; }
    __syncthreads();
    if (lane < 32) *(LAS u32x4*)(Ht + lane * HTP + 288) = (u32x4){0u, 0u, 0u, 0u};
    if (lane < 32) *(LAS u32x4*)(Ht + lane * HTP + 304) = (u32x4){0u, 0u, 0u, 0u};
    *(LAS bf16x8*)(Ht + (16 * Hc + reg) * HTP + 256 + 16 * H) = af;
    S5_BU(af);
#pragma unroll
    for (int q = 0; q < 2; ++q) { const size_t so = ((size_t)(bbase + 2 * H + q) * 128 + gi) * 64;
        float hr0 = h0v[q][0], hi0 = h0v[q][1], hr1 = h0v[q][2], hi1 = h0v[q][3];
#pragma unroll
        for (int t = 8 * q; t < 8 * q + 8; ++t) { S5_STEP(t); S5_PUT(t); }
        C.out[O_S5RS + so + r] = hr0; C.out[O_S5IS + so + r] = hi0; C.out[O_S5RS + so + 32 + r] = hr1; C.out[O_S5IS + so + 32 + r] = hi1; }
    asm volatile("s_waitcnt lgkmcnt(0)" ::: "memory");
    f32x4 yv[2]; s5_y(T, Ht, lane, yv);
#pragma unroll
    for (int mt = 0; mt < 2; ++mt)
#pragma unroll
        for (int q = 0; q < 4; ++q) *(LAS unsigned short*)(Yw + (16 * mt + 4 * gq + q) * YWP + 2 * fr) = f2bf(gelu_tanh_f(yv[mt][q]));
    asm volatile("s_waitcnt lgkmcnt(0)" ::: "memory");
    { const int row = lane >> 1, t = row & 15; const size_t tok = (size_t)TP + (size_t)(bbase + 2 * (row >> 4) + (t >> 3)) * 8 + (t & 7);
      *(u32x2*)((unsigned char*)C.GL + tok * LDG8 + gi * 16 + 8 * (lane & 1)) = bf8_to_fp8(*(const LAS u32x4*)(Yw + row * YWP + 16 * (lane & 1)), ACS); }
}

__device__ __forceinline__ void xattn_prompt_unit(const Ctx& C, LAS unsigned char* lds, int b, int hx, int qb) {
    const int tid = C.tid, lane = C.lane, w = C.wave, fr = lane & 15, gq = lane >> 4;
    LAS unsigned char* Ks = lds; LAS unsigned char* Pw = lds + 69632 + w * 8448;
    const bf16_t* Z = C.Z; const bf16_t* KVB = C.KVB;
    const size_t rowbase = (size_t)b * 2048 + 128 * qb + 16 * w;
    f32x4 S[16];
#pragma unroll
    for (int i = 0; i < 16; ++i) S[i] = (f32x4){0.f, 0.f, 0.f, 0.f};
    u32x4 kpre[8]; bf16x8 a[4];
#pragma unroll
    for (int s = 0; s < 8; ++s) { const int p = tid + 512 * s; kpre[s] = *(const u32x4*)(KVB + (size_t)(b * 256 + (p >> 4)) * 4096 + hx * 512 + 8 * (p & 15)); }
#pragma unroll
    for (int ks = 0; ks < 4; ++ks) a[ks] = *(const bf16x8*)(Z + (rowbase + fr) * ZLD + ZQX + hx * 512 + 32 * ks + 8 * gq);
#pragma unroll 1
    for (int sl = 0; sl < 4; ++sl) {
        __syncthreads();
#pragma unroll
        for (int s = 0; s < 8; ++s) { const int p = tid + 512 * s; *(LAS u32x4*)(Ks + (p >> 4) * 272 + 16 * (p & 15)) = kpre[s]; }
        bf16x8 ac[4];
#pragma unroll
        for (int ks = 0; ks < 4; ++ks) ac[ks] = a[ks];
        if (sl < 3) {
#pragma unroll
            for (int s = 0; s < 8; ++s) { const int p = tid + 512 * s; kpre[s] = *(const u32x4*)(KVB + (size_t)(b * 256 + (p >> 4)) * 4096 + hx * 512 + 128 * (sl + 1) + 8 * (p & 15)); }
#pragma unroll
            for (int ks = 0; ks < 4; ++ks) a[ks] = *(const bf16x8*)(Z + (rowbase + fr) * ZLD + ZQX + hx * 512 + 128 * (sl + 1) + 32 * ks + 8 * gq); }
        __syncthreads();
#pragma unroll
        for (int nt = 0; nt < 16; ++nt)
#pragma unroll
            for (int ks = 0; ks < 4; ++ks) { const bf16x8 bb = *(const LAS bf16x8*)(Ks + (16 * nt + fr) * 272 + (32 * ks + 8 * gq) * 2); S[nt] = mfma16(ac[ks], bb, S[nt]); }
    }
#pragma unroll
    for (int r = 0; r < 4; ++r) { float mx = S[0][r];
#pragma unroll
        for (int nt = 1; nt < 16; ++nt) mx = fmaxf(mx, S[nt][r]);
        mx = row16_max(mx);
        float sum = 0.f;
#pragma unroll
        for (int nt = 0; nt < 16; ++nt) { const float e = __expf(S[nt][r] - mx); S[nt][r] = e; sum += e; }
        sum = row16_sum(sum);
        const float inv = 1.0f / sum;
#pragma unroll
        for (int nt = 0; nt < 16; ++nt) *(LAS unsigned short*)(Pw + (4 * gq + r) * 528 + (16 * nt + fr) * 2) = f2bf(S[nt][r] * inv); }
    constexpr int VSP = 144, OWP = 144;
    LAS unsigned char* Ow = lds + 36864 + w * (16 * OWP);
    const unsigned trv = (unsigned)(size_t)(Ks + VSP * (8 * gq + (fr >> 2)) + 8 * (fr & 3));
    u32x4 vpre[4];
#pragma unroll
    for (int s = 0; s < 4; ++s) { const int p = tid + 512 * s; vpre[s] = *(const u32x4*)(KVB + (size_t)(b * 256 + (p >> 3)) * 4096 + 2048 + hx * 512 + 8 * (p & 7)); }
#pragma unroll 1
    for (int es = 0; es < 8; ++es) {
        __syncthreads();
#pragma unroll
        for (int s = 0; s < 4; ++s) { const int p = tid + 512 * s; *(LAS u32x4*)(Ks + (p >> 3) * VSP + 16 * (p & 7)) = vpre[s]; }
        if (es < 7) {
#pragma unroll
            for (int s = 0; s < 4; ++s) { const int p = tid + 512 * s; vpre[s] = *(const u32x4*)(KVB + (size_t)(b * 256 + (p >> 3)) * 4096 + 2048 + hx * 512 + 64 * (es + 1) + 8 * (p & 7)); } }
        __syncthreads();
        u32x2 gpre[2];
#pragma unroll
        for (int i = 0; i < 2; ++i) { const int pc = lane + 64 * i; gpre[i] = *(const u32x2*)gate8(Z, rowbase + (pc >> 3), ZGX, hx * 512 + 64 * es + 8 * (pc & 7)); }
        f32x4 o[4];
#pragma unroll
        for (int nt = 0; nt < 4; ++nt) o[nt] = (f32x4){0.f, 0.f, 0.f, 0.f};
#define XP_PV(j) do { const bf16x8 a0 = *(const LAS bf16x8*)(Pw + fr * 528 + (64 * (j) + 8 * gq) * 2), a1 = *(const LAS bf16x8*)(Pw + fr * 528 + (64 * (j) + 32 + 8 * gq) * 2); bf16x8 b0, b1; \
            tr_frag2<VSP * 64 * (j), VSP * 64 * (j) + 4 * VSP, VSP * 64 * (j) + 32 * VSP, VSP * 64 * (j) + 36 * VSP>(trv, b0, b1); o[0] = mfma16(a0, b0, o[0]); o[0] = mfma16(a1, b1, o[0]); \
            tr_frag2<32 + VSP * 64 * (j), 32 + VSP * 64 * (j) + 4 * VSP, 32 + VSP * 64 * (j) + 32 * VSP, 32 + VSP * 64 * (j) + 36 * VSP>(trv, b0, b1); o[1] = mfma16(a0, b0, o[1]); o[1] = mfma16(a1, b1, o[1]); \
            tr_frag2<64 + VSP * 64 * (j), 64 + VSP * 64 * (j) + 4 * VSP, 64 + VSP * 64 * (j) + 32 * VSP, 64 + VSP * 64 * (j) + 36 * VSP>(trv, b0, b1); o[2] = mfma16(a0, b0, o[2]); o[2] = mfma16(a1, b1, o[2]); \
            tr_frag2<96 + VSP * 64 * (j), 96 + VSP * 64 * (j) + 4 * VSP, 96 + VSP * 64 * (j) + 32 * VSP, 96 + VSP * 64 * (j) + 36 * VSP>(trv, b0, b1); o[3] = mfma16(a0, b0, o[3]); o[3] = mfma16(a1, b1, o[3]); } while (0)
        XP_PV(0); XP_PV(1); XP_PV(2); XP_PV(3);
#undef XP_PV
#pragma unroll
        for (int nt = 0; nt < 4; ++nt)
#pragma unroll
            for (int r = 0; r < 4; ++r) *(LAS unsigned short*)(Ow + (4 * gq + r) * OWP + (16 * nt + fr) * 2) = f2bf(o[nt][r]);
        asm volatile("s_waitcnt lgkmcnt(0)" ::: "memory");
#pragma unroll
        for (int i = 0; i < 2; ++i) { const int pc = lane + 64 * i, row = pc >> 3, c8 = pc & 7;
            const u32x4 ov = *(const LAS u32x4*)(Ow + row * OWP + 16 * c8);
            float gv[8]; unpack8_fp8(gpre[i], gv);
            float pv[8];
#pragma unroll
            for (int q = 0; q < 4; ++q) { pv[2 * q] = __uint_as_float(ov[q] << 16) * gv[2 * q] * (ACS / GSC); pv[2 * q + 1] = __uint_as_float(ov[q] & 0xffff0000u) * gv[2 * q + 1] * (ACS / GSC); }
            u32x2 wv; wv.x = pk4_fp8(pv[0], pv[1], pv[2], pv[3]); wv.y = pk4_fp8(pv[4], pv[5], pv[6], pv[7]);
            *(u32x2*)(C.A8 + (rowbase + row) * LDA8 + AC_X + hx * 512 + 64 * es + 8 * c8) = wv; }
        asm volatile("s_waitcnt lgkmcnt(0)" ::: "memory");
    }
}
struct XsK { bf16x8 a[4]; f32x4 x[4][2][2]; };
__device__ __forceinline__ void xs_kload(XsK& g, const bf16_t* zq, const float* kp, int grp, int fr) {
#pragma unroll
    for (int s = 0; s < 4; ++s) { const int ks = 4 * grp + s;
        g.a[s] = (bf16x8){0, 0, 0, 0, 0, 0, 0, 0};
        if (fr < 8) g.a[s] = *(const bf16x8*)(zq + 32 * ks);
#pragma unroll
        for (int nt = 0; nt < 2; ++nt) { const float* p = kp + (size_t)nt * (16 * 2048) + 32 * ks; g.x[s][nt][0] = *(const f32x4*)p; g.x[s][nt][1] = *(const f32x4*)(p + 4); } }
}
__device__ __forceinline__ void xs_kmma(const XsK& g, f32x4 (&S2)[2]) {
#pragma unroll
    for (int s = 0; s < 4; ++s)
#pragma unroll
        for (int nt = 0; nt < 2; ++nt) { const f32x4 x0 = g.x[s][nt][0], x1 = g.x[s][nt][1];
            u32x4 wv; wv.x = cvt_pk_bf16(x0[0], x0[1]); wv.y = cvt_pk_bf16(x0[2], x0[3]); wv.z = cvt_pk_bf16(x1[0], x1[1]); wv.w = cvt_pk_bf16(x1[2], x1[3]);
            S2[nt] = mfma16(g.a[s], __builtin_bit_cast(bf16x8, wv), S2[nt]); }
}
__device__ __forceinline__ void xs_vload(f32x4 (&vv)[16], const float* vp, int k0) {
#pragma unroll
    for (int kk = 0; kk < 16; ++kk) vv[kk] = *(const f32x4*)(vp + (size_t)(k0 + kk) * 2048);
}
__device__ __forceinline__ void xs_vfma(const f32x4 (&vv)[16], f32x4 (&o)[8], const LAS float* PT, int key0) {
#pragma unroll
    for (int kk = 0; kk < 16; ++kk) { const f32x4 p0 = *(const LAS f32x4*)(PT + (key0 + kk) * 8), p1 = *(const LAS f32x4*)(PT + (key0 + kk) * 8 + 4);
#pragma unroll
        for (int i = 0; i < 4; ++i) { o[i] += vv[kk] * p0[i]; o[4 + i] += vv[kk] * p1[i]; } }
}
__device__ __forceinline__ void xattn_sample_unit(const Ctx& C, LAS unsigned char* lds, int b, int hx) {
    const int lane = C.lane, w = C.wave, fr = lane & 15, gq = lane >> 4;
    LAS float* Ssm = (LAS float*)lds;
    LAS float* PT = (LAS float*)(lds + 8192);
    LAS float* red = (LAS float*)(lds + 16384);
    const bf16_t* Z = C.Z; const float* CK = C.in[6]; const float* CV = C.in[7];
    const size_t t0 = (size_t)TP + (size_t)b * 8;
    f32x4 S2[2] = {(f32x4){0.f, 0.f, 0.f, 0.f}, (f32x4){0.f, 0.f, 0.f, 0.f}};
    const bf16_t* zq = Z + (t0 + (fr & 7)) * ZLD + ZQX + hx * 512 + 8 * gq;
    const float* kp = CK + ((size_t)(b * 256 + 32 * w + fr) * 4 + hx) * 512 + 8 * gq;
    const int kg = w >> 1, e4 = 256 * (w & 1) + 4 * lane;
    const float* vp = CV + ((size_t)(b * 256 + 64 * kg) * 4 + hx) * 512 + e4;
    unsigned gpre[2];
#pragma unroll
    for (int j = 0; j < 2; ++j) gpre[j] = *(const unsigned*)gate8(Z, t0 + w, ZGX, hx * 512 + 4 * lane + 256 * j);
    __syncthreads();
    { XsK ga, gb;
      xs_kload(ga, zq, kp, 0, fr);
      xs_kload(gb, zq, kp, 1, fr); xs_kmma(ga, S2);
      xs_kload(ga, zq, kp, 2, fr); xs_kmma(gb, S2);
      xs_kload(gb, zq, kp, 3, fr); xs_kmma(ga, S2);
      xs_kmma(gb, S2); }
    f32x4 va[16], vb[16];
    xs_vload(va, vp, 0);
    if (gq < 2) {
#pragma unroll
        for (int nt = 0; nt < 2; ++nt)
#pragma unroll
            for (int r = 0; r < 4; ++r) Ssm[(4 * gq + r) * 256 + 32 * w + 16 * nt + fr] = S2[nt][r]; }
    __syncthreads();
    { const f32x4 sv = *(const LAS f32x4*)(Ssm + w * 256 + 4 * lane);
      const float mx = wave_max(fmaxf(fmaxf(sv[0], sv[1]), fmaxf(sv[2], sv[3])));
      f32x4 e; e[0] = __expf(sv[0] - mx); e[1] = __expf(sv[1] - mx); e[2] = __expf(sv[2] - mx); e[3] = __expf(sv[3] - mx);
      const float inv = 1.0f / wave_sum((e[0] + e[1]) + (e[2] + e[3]));
#pragma unroll
      for (int j = 0; j < 4; ++j) PT[(4 * lane + j) * 8 + w] = e[j] * inv; }
    __syncthreads();
    { f32x4 o[8];
#pragma unroll
      for (int i = 0; i < 8; ++i) o[i] = (f32x4){0.f, 0.f, 0.f, 0.f};
      xs_vload(vb, vp, 16); xs_vfma(va, o, PT, 64 * kg);
      xs_vload(va, vp, 32); xs_vfma(vb, o, PT, 64 * kg + 16);
      xs_vload(vb, vp, 48); xs_vfma(va, o, PT, 64 * kg + 32);
      xs_vfma(vb, o, PT, 64 * kg + 48);
#pragma unroll
      for (int i = 0; i < 8; ++i) *(LAS f32x4*)(red + (kg * 8 + i) * 512 + e4) = o[i]; }
    __syncthreads();
#pragma unroll
    for (int j = 0; j < 2; ++j) { const int e = 4 * lane + 256 * j; f32x4 a = (f32x4){0.f, 0.f, 0.f, 0.f};
#pragma unroll
        for (int kg2 = 0; kg2 < 4; ++kg2) a += *(const LAS f32x4*)(red + (kg2 * 8 + w) * 512 + e);
        float g4[4]; unpack4_fp8(gpre[j], g4);
        *(unsigned*)(C.A8 + (t0 + w) * LDA8 + AC_X + hx * 512 + e) = pk4_fp8(a[0] * g4[0] * (ACS / GSC), a[1] * g4[1] * (ACS / GSC), a[2] * g4[2] * (ACS / GSC), a[3] * g4[3] * (ACS / GSC)); }
}

constexpr int U_RP = 64, U_XP = 256, U_SP = 512, U_SS = 512, U_XS = 512, U_RS = 2048;
constexpr int U_TOTAL = U_RP + U_XP + U_SP + U_SS + U_XS + U_RS;
__device__ __forceinline__ int q_fetch(const Ctx& C, unsigned* q, volatile LAS unsigned* slot) {
    __syncthreads();
    if (C.tid == 0) *slot = __hip_atomic_fetch_add(q, 1u, __ATOMIC_RELAXED, __HIP_MEMORY_SCOPE_AGENT);
    __syncthreads();
    return (int)__builtin_amdgcn_readfirstlane(*slot);
}
#define Q_LOOP(qptr, N, U, CALL) do { int id = q_fetch(C, (qptr), slot); \
    _Pragma("unroll 1") while (id < (N)) { unsigned nx_ = 0u; if (C.tid == 0) nx_ = __hip_atomic_fetch_add((qptr), 1u, __ATOMIC_RELAXED, __HIP_MEMORY_SCOPE_AGENT); \
        id %= (U); CALL; __syncthreads(); if (C.tid == 0) *slot = nx_; __syncthreads(); id = (int)__builtin_amdgcn_readfirstlane(*slot); } } while (0)
#ifndef P2_NSTREAM
#define P2_NSTREAM 3
#endif
__device__ __forceinline__ void p2_streams(const Ctx& C, LAS unsigned char* lds, unsigned* queue, volatile LAS unsigned* slot) {
#ifndef DIS_XS
#pragma unroll 1
    Q_LOOP(queue + 256, REP_XS * U_XS, U_XS, xattn_sample_unit(C, lds, id >> 2, id & 3));
#endif
#ifndef DIS_RS
    ret_sample_stream(C, lds, queue + 320, slot, REP_RS * U_RS);
#endif
}
__device__ __forceinline__ void p2_mixers(const Ctx& C, LAS unsigned char* lds, unsigned* queue, volatile LAS unsigned* slot) {
    if (((C.bid >> 3) & 7) < P2_NSTREAM) p2_streams(C, lds, queue, slot);
#ifndef DIS_RP
#pragma unroll 1
    for (;;) { int id = q_fetch(C, queue, slot); if (id >= REP_RP * U_RP) break; id %= U_RP; ret_prompt_unit(C, lds, id >> 4, id & 15); }
#endif
#ifndef DIS_XP
#pragma unroll 1
    Q_LOOP(queue + 64, REP_XP * U_XP, U_XP, xattn_prompt_unit(C, lds, id >> 6, (id >> 4) & 3, id & 15));
#endif
#ifndef DIS_SP
#pragma unroll 1
    Q_LOOP(queue + 128, REP_SP * U_SP, U_SP, s5_prompt_unit(C, lds, id >> 7, id & 127));
#endif
#ifndef DIS_SS
#pragma unroll 1
    Q_LOOP(queue + 192, REP_SS * U_SS, U_SS, s5_sample_unit(C, lds, id & 127, id >> 7));
#endif
    p2_streams(C, lds, queue, slot);
}

__device__ __forceinline__ void p6_layernorm(const Ctx& C) {
    const int gw = C.bid * 8 + C.wave, NGW = C.G * 8;
    const float* lg = C.in[23]; const float* lb = C.in[24];
    f32x4 gg[16], bb[16];
#pragma unroll
    for (int j = 0; j < 8; ++j) { const int c4 = 128 * j + 2 * C.lane;
        gg[2 * j] = ((const f32x4*)lg)[c4]; gg[2 * j + 1] = ((const f32x4*)lg)[c4 + 1]; bb[2 * j] = ((const f32x4*)lb)[c4]; bb[2 * j + 1] = ((const f32x4*)lb)[c4 + 1]; }
    u32x4 wn[8];
    if (gw < TT) { const u32x4* vp = (const u32x4*)(C.ACAT + (size_t)gw * ALD) + C.lane;
#pragma unroll
        for (int j = 0; j < 8; ++j) wn[j] = vp[64 * j]; }
#pragma unroll 1
    for (int row = gw; row < TT; row += NGW) {
        f32x4 v[16]; float s = 0.f;
#pragma unroll
        for (int j = 0; j < 8; ++j) { const u32x4 w = wn[j];
            v[2 * j] = (f32x4){__uint_as_float(w.x << 16), __uint_as_float(w.x & 0xffff0000u), __uint_as_float(w.y << 16), __uint_as_float(w.y & 0xffff0000u)};
            v[2 * j + 1] = (f32x4){__uint_as_float(w.z << 16), __uint_as_float(w.z & 0xffff0000u), __uint_as_float(w.w << 16), __uint_as_float(w.w & 0xffff0000u)};
            s += ((v[2 * j][0] + v[2 * j][1]) + (v[2 * j][2] + v[2 * j][3])) + ((v[2 * j + 1][0] + v[2 * j + 1][1]) + (v[2 * j + 1][2] + v[2 * j + 1][3])); }
        if (row + NGW < TT) { const u32x4* vp = (const u32x4*)(C.ACAT + (size_t)(row + NGW) * ALD) + C.lane;
#pragma unroll
            for (int j = 0; j < 8; ++j) wn[j] = vp[64 * j]; }
        const float mean = wave_sum(s) * (1.f / DM); float q = 0.f;
#pragma unroll
        for (int j = 0; j < 16; ++j) { v[j] = v[j] - mean; q += (v[j][0] * v[j][0] + v[j][1] * v[j][1]) + (v[j][2] * v[j][2] + v[j][3] * v[j][3]); }
        const float rstd = rsqrtf(wave_sum(q) * (1.f / DM) + 1e-5f);
        f32x4* op = (f32x4*)(C.out + (size_t)row * DM) + 2 * C.lane;
#pragma unroll
        for (int j = 0; j < 8; ++j) { op[128 * j] = v[2 * j] * rstd * gg[2 * j] + bb[2 * j]; op[128 * j + 1] = v[2 * j + 1] * rstd * gg[2 * j + 1] + bb[2 * j + 1]; }
    }
}

__global__ void __launch_bounds__(512, 2) mk_fwd(Args args) {
    extern __shared__ __attribute__((aligned(16))) unsigned char lds_raw[];
    LAS unsigned char* lds = (LAS unsigned char*)lds_raw;
    Ctx C;
    C.in = args.in; C.out = args.out; C.ws = args.ws; C.lg2g = args.lg2g;
    C.tid = threadIdx.x; C.lane = C.tid & 63; C.wave = __builtin_amdgcn_readfirstlane(C.tid >> 6); C.G = gridDim.x; C.bid = blockIdx.x;
    unsigned char* ws = args.ws;
    C.XB = (bf16_t*)(ws + WS_XB); C.MEMB = (bf16_t*)(ws + WS_MEMB); C.WIN = (bf16_t*)(ws + WS_WIN); C.WMKV = (bf16_t*)(ws + WS_WMKV); C.WGLU = (bf16_t*)(ws + WS_WGLU);
    C.WCAT = (bf16_t*)(ws + WS_WCAT); C.WOUT = (bf16_t*)(ws + WS_WOUT); C.Z = (bf16_t*)(ws + WS_Z); C.ACAT = (bf16_t*)(ws + WS_ACAT); C.A8 = ws + WS_ACAT; C.GL = (bf16_t*)(ws + WS_GL);
    C.MERGED = (bf16_t*)(ws + WS_MERGED); C.KVB = (bf16_t*)(ws + WS_KVB); C.ROPE = (float*)(ws + WS_ROPE); C.S5T = ws + WS_S5;
    unsigned* ctl = (unsigned*)(ws + WS_CTL);
    volatile LAS unsigned* MISC = (volatile LAS unsigned*)(lds + LDS_BYTES - 64);
    if (C.tid < 16) MISC[C.tid] = 0u;
    __syncthreads();
    const int lo = args.ph_lo, hi = args.ph_hi;
    const bool use_bar = (hi - lo) > 1;
    XcdBarrier bar; bar.bar = ctl + CW_BAR; bar.x = 0; bar.st = nullptr;
    if (use_bar) bar = xcd_barrier_post(ctl + CW_BAR, MISC + 8);
#define IN(k) (lo <= (k) && (k) < hi)
    const int su_tl = C.bid >> 2, su_kq = C.bid & 3;
    unsigned char* su_slab = ws + WS_SLAB + (size_t)su_tl * 4 * SLAB_BYTES;
#define SEAM(k) do { if (IN(k) && IN((k) + 1)) xcd_barrier(bar); } while (0)

#ifndef DIS_P0
    if (IN(0)) {
#pragma unroll 1
        for (int rep = 0; rep < REP_P0; ++rep) { if (rep) xcd_barrier(bar); p0_prologue(C, lds); } }
#endif
    SEAM(0);
    if (IN(1)) {
#ifndef DIS_P1A
        {
          pg8::Gemm g{(const bf16_t*)(ws + WS_XB8), (const bf16_t*)(ws + WS_WIN8), TT, 24576, DM / 2, LD8 / 2, LD8 / 2}; pg8::StaticOrder S; S.init(TT, 24576, C.G, C.bid); EpiZ E{C.Z, C.ROPE, C.lg2g, 2, ws + WS_ZM8};
          pg8::gemm_phase<EpiZ, pg8::StaticOrder, PG8_ALIGN, PG8_SP2, true>(lds, g, S, E); }
        {
          pg8::Gemm g{C.XB, C.WIN, TT, 8192, DM, LDX, LDX}; pg8::StaticOrder S; S.init(TT, 8192, C.G, C.G - 1 - C.bid); EpiZ E{C.Z, C.ROPE, C.lg2g, 1, ws + WS_ZM8};
          pg8::gemm_phase<EpiZ, pg8::StaticOrder, PG8_ALIGN, PG8_SP2>(lds, g, S, E); }
#endif
#ifndef DIS_P1B
        if (C.bid < 128) {
          const int mt = C.bid >> 1, mh2 = C.bid & 1;
          pg8::Gemm g{C.MEMB + mh2 * 2048, C.WMKV + mh2 * 2048, 1024, DM, 2048, LDX, LDX}; OneUnit S{Unit{mt >> 4, mt & 15}};
          EpiSplit<EpiKV, 2> E{EpiKV{C.out + O_MK, C.out + O_MV, C.KVB}, ws + WS_SLAB + (size_t)mt * 4 * SLAB_BYTES, ctl + CW_TICKET + (0 * 64 + mt) * 64, mh2};
          pg8::gemm_phase<EpiSplit<EpiKV, 2>, OneUnit, false, PG8_SP2>(lds, g, S, E); }
#endif
    } SEAM(1);
    if (IN(2)) { p2_mixers(C, lds, ctl + CW_QUEUE, MISC + 4); }
    SEAM(2);
#ifndef DIS_P3
    if (IN(3)) {
        { pg8::Gemm g{C.GL, C.WGLU, TP, DM, 1024, LDG8 / 2, LDG8 / 2, 0x7c78}; pg8::StaticOrder S; S.init(TP, DM, C.G, C.bid); EpiGlu E{C.Z, C.A8};
          pg8::gemm_phase<EpiGlu, pg8::StaticOrder, PG8_ALIGN, PG8_SP2, true>(lds, g, S, E); }
        if (C.bid < 256) { pg8::Gemm g{C.GL + su_kq * 256, C.WGLU + su_kq * 256, TT, DM, 256, LDG8 / 2, LDG8 / 2, 0x7c78}; OneUnit S{Unit{32 + (su_tl >> 4), su_tl & 15}};
          EpiSplit<EpiGlu> E{EpiGlu{C.Z, C.A8}, su_slab, ctl + CW_TICKET + (1 * 64 + su_tl) * 64, su_kq};
          pg8::gemm_phase<EpiSplit<EpiGlu>, OneUnit, false, PG8_SP2, true>(lds, g, S, E); } }
#endif
    SEAM(3);
#ifndef DIS_P4
    if (IN(4)) {
        { pg8::Gemm g{C.ACAT, C.WCAT, TP, DM, 4096, LDA8 / 2, LDA8 / 2, 0x7c78}; pg8::StaticOrder S; S.init(TP, DM, C.G, C.bid); EpiProj E{ws + WS_ZM8, (unsigned char*)C.MERGED};
          pg8::gemm_phase<EpiProj, pg8::StaticOrder, PG8_ALIGN, PG8_SP2, true>(lds, g, S, E); }
        if (C.bid < 256) { pg8::Gemm g{C.ACAT + su_kq * 1024, C.WCAT + su_kq * 1024, TT, DM, 1024, LDA8 / 2, LDA8 / 2, 0x7c78}; OneUnit S{Unit{32 + (su_tl >> 4), su_tl & 15}};
          EpiSplit<EpiProjQ> E{EpiProjQ{ws + WS_ZM8, (unsigned char*)C.MERGED}, su_slab, ctl + CW_TICKET + (2 * 64 + su_tl) * 64, su_kq};
          pg8::gemm_phase<EpiSplit<EpiProjQ>, OneUnit, false, PG8_SP2, true>(lds, g, S, E); } }
#endif
    SEAM(4);
#ifndef DIS_P5
    if (IN(5)) {
        { pg8::Gemm g{C.MERGED, C.WOUT, TP, DM, DM / 2, LD8 / 2, LD8 / 2, 0x7b78}; pg8::StaticOrder S; S.init(TP, DM, C.G, C.bid); EpiOut E{C.XB, C.ACAT};
          pg8::gemm_phase<EpiOut, pg8::StaticOrder, PG8_ALIGN, PG8_SP2, true>(lds, g, S, E); }
        if (C.bid < 256) { pg8::Gemm g{C.MERGED + su_kq * 512, C.WOUT + su_kq * 512, TT, DM, 512, LD8 / 2, LD8 / 2, 0x7b78}; OneUnit S{Unit{32 + (su_tl >> 4), su_tl & 15}};
          EpiSplit<EpiOut> E{EpiOut{C.XB, C.ACAT}, su_slab, ctl + CW_TICKET + (3 * 64 + su_tl) * 64, su_kq};
          pg8::gemm_phase<EpiSplit<EpiOut>, OneUnit, false, PG8_SP2, true>(lds, g, S, E); } }
#endif
    SEAM(5);
#ifndef DIS_P6
    if (IN(6)) { p6_layernorm(C); }
#endif
#undef IN
#undef SEAM
}

extern "C" void kernel_launch(void* const* d_in, const int* in_sizes, int n_in, void* d_out, int out_size, void* d_ws, size_t ws_size, hipStream_t stream) {
    static int grid = 0;
    if (grid == 0) {
        if (n_in != 25 || (size_t)out_size != O_END || ws_size < WS_END) { fprintf(stderr, "kernel_launch: unexpected shapes (n_in %d, out %d, ws %zu)\n", n_in, out_size, ws_size); grid = -1; return; }
        int dev = 0, cus = 0, per_cu = 0;
        if (hipGetDevice(&dev) != hipSuccess || hipDeviceGetAttribute(&cus, hipDeviceAttributeMultiprocessorCount, dev) != hipSuccess) { grid = -1; return; }
        if (hipFuncSetAttribute((const void*)mk_fwd, hipFuncAttributeMaxDynamicSharedMemorySize, LDS_BYTES) != hipSuccess) { fprintf(stderr, "kernel_launch: hipFuncSetAttribute failed\n"); grid = -1; return; }
        if (hipOccupancyMaxActiveBlocksPerMultiprocessor(&per_cu, (const void*)mk_fwd, 512, LDS_BYTES) != hipSuccess || per_cu < 1) fprintf(stderr, "kernel_launch: occupancy query says %d\n", per_cu);
        (void)hipGetLastError();
        grid = cus;
        if (grid != 256) { fprintf(stderr, "kernel_launch: built for 256 CUs, found %d\n", cus); grid = -1; return; }
    }
    if (grid < 0) return;
    (void)hipMemsetAsync((char*)d_ws + WS_CTL, 0, CTL_ZERO_BYTES, stream);
    Args a{};
    for (int i = 0; i < 25; ++i) a.in[i] = (const float*)d_in[i];
    a.out = (float*)d_out; a.ws = (unsigned char*)d_ws;
    for (int h = 0; h < 16; ++h) a.lg2g[h] = (float)(log1p(-exp2(-5.0 - (double)h)) / log(2.0));
    constexpr int NPH = 7;
    if (MK_N_LAUNCHES == 1) { a.ph_lo = 0; a.ph_hi = NPH; hipLaunchKernelGGL(mk_fwd, dim3(grid), dim3(512), LDS_BYTES, stream, a); }
    else for (int p = 0; p < NPH; ++p) { a.ph_lo = p; a.ph_hi = p + 1; hipLaunchKernelGGL(mk_fwd, dim3(grid), dim3(512), LDS_BYTES, stream, a); }
}
```
